# Optimizing an MI355X kernel written in HIP

```python
import math
import jax, jax.numpy as jnp
from jax import lax
import numpy as np

D_MODEL = 2048
BATCH = 2
SEQ = 8192
DEPTH = 1

HEAD_DIM = 128
DIL_GROUPS = ((128, 1), (512, 4), (2048, 16))
N_DIL_GROUPS = 3
HEADS_PER_DIL = 4
N_HEADS_A = N_DIL_GROUPS * HEADS_PER_DIL
N_Q_B = 8
N_KV_B = 2
Q_PER_KV = N_Q_B // N_KV_B
GRID_W = 64
ROPE_THETA = 10000.0
ALIBI_MAX = 8.0
D_FF = 5632
N_MOD = 9
Q_BLOCK = 128
EPS = 1e-6

D_A = N_HEADS_A * HEAD_DIM
D_A_OUT = HEADS_PER_DIL * HEAD_DIM
D_QB = N_Q_B * HEAD_DIM
D_KVB = N_KV_B * HEAD_DIM
SPLIT_POINTS = (D_A, 2 * D_A, 3 * D_A,
                3 * D_A + D_QB, 3 * D_A + D_QB + D_KVB, 3 * D_A + D_QB + 2 * D_KVB,
                3 * D_A + D_QB + 2 * D_KVB + D_MODEL)
D_IN = 3 * D_A + D_QB + 2 * D_KVB + 2 * D_MODEL

kernel_name = "hybrid_dilated_axial_gqa_macaron_adaln"


def rms_norm(x, g):
    xf = x.astype(jnp.float32)
    y = xf * lax.rsqrt(jnp.mean(xf * xf, axis=-1, keepdims=True) + EPS)
    return (y * g.astype(jnp.float32)).astype(x.dtype)


def modulate(x, shift, scale):
    return x * (1.0 + scale[:, None, :]) + shift[:, None, :]


def swiglu(x, w1, w3, w2):
    return (jax.nn.silu(x @ w1) * (x @ w3)) @ w2


def axial_rope_tables(s):
    rows = s // GRID_W
    row = jnp.repeat(jnp.arange(rows), GRID_W).astype(jnp.float32)
    col = jnp.tile(jnp.arange(GRID_W), rows).astype(jnp.float32)
    half = HEAD_DIM // 2
    inv_freq = ROPE_THETA ** (-jnp.arange(0, half, 2, dtype=jnp.float32) / half)
    ang = jnp.concatenate([row[:, None] * inv_freq, col[:, None] * inv_freq], axis=-1)
    return jnp.cos(ang), jnp.sin(ang)


def apply_rope(x, cos, sin):
    xf = x.astype(jnp.float32)
    half = HEAD_DIM // 2
    x1, x2 = xf[..., :half], xf[..., half:]
    c = cos[None, :, None, :]
    s = sin[None, :, None, :]
    return jnp.concatenate([x1 * c - x2 * s, x1 * s + x2 * c], axis=-1).astype(x.dtype)


def dilated_attention(qa, ka, va, slopes):
    b, s = qa.shape[0], qa.shape[1]
    nblk = s // Q_BLOCK
    scale = HEAD_DIM ** -0.5
    k_groups = [ka[:, :, g] for g in range(N_DIL_GROUPS)]
    v_groups = [va[:, :, g] for g in range(N_DIL_GROUPS)]

    def block(i):
        start = i * Q_BLOCK
        t = start + jnp.arange(Q_BLOCK)
        q_blk = lax.dynamic_slice_in_dim(qa, start, Q_BLOCK, axis=1)
        outs, lses = [], []
        for g, (window, dil) in enumerate(DIL_GROUPS):
            half = window // (2 * dil)
            n_keys = 2 * half + 1
            offs = dil * jnp.arange(-half, half + 1)
            idx = t[:, None] + offs[None, :]
            valid = (idx >= 0) & (idx < s)
            flat = jnp.clip(idx, 0, s - 1).reshape(-1)
            k_sel = jnp.take(k_groups[g], flat, axis=1).reshape(b, Q_BLOCK, n_keys, HEADS_PER_DIL, HEAD_DIM)
            v_sel = jnp.take(v_groups[g], flat, axis=1).reshape(b, Q_BLOCK, n_keys, HEADS_PER_DIL, HEAD_DIM)
            scores = jnp.einsum('bqhd,bqjhd->bhqj', q_blk[:, :, g], k_sel,
                                preferred_element_type=jnp.float32) * scale
            scores = scores - slopes[g][None, :, None, None] * jnp.abs(offs).astype(jnp.float32)[None, None, None, :]
            scores = jnp.where(valid[None, None], scores, -jnp.inf)
            lse = jax.nn.logsumexp(scores, axis=-1)
            p = jnp.exp(scores - lse[..., None])
            o = jnp.einsum('bhqj,bqjhd->bqhd', p.astype(va.dtype), v_sel,
                           preferred_element_type=jnp.float32)
            outs.append(o)
            lses.append(lse)
        lse_all = jnp.stack(lses, axis=0)
        wts = jax.nn.softmax(lse_all, axis=0)
        wts = jnp.transpose(wts, (0, 1, 3, 2))[..., None]
        o = jnp.sum(wts * jnp.stack(outs, axis=0), axis=0)
        return o.astype(qa.dtype)

    o = lax.map(block, jnp.arange(nblk))
    return jnp.transpose(o, (1, 0, 2, 3, 4)).reshape(b, s, D_A_OUT)


def gqa_attention(qb, kb, vb):
    b, s = qb.shape[0], qb.shape[1]
    nblk = s // Q_BLOCK
    scale = HEAD_DIM ** -0.5
    q_blocks = jnp.moveaxis(qb.reshape(b, nblk, Q_BLOCK, N_KV_B, Q_PER_KV, HEAD_DIM), 1, 0)

    def block(q_blk):
        scores = jnp.einsum('bqkgd,bskd->bkgqs', q_blk, kb,
                            preferred_element_type=jnp.float32) * scale
        p = jax.nn.softmax(scores, axis=-1)
        return jnp.einsum('bkgqs,bskd->bqkgd', p.astype(vb.dtype), vb)

    o = lax.map(block, q_blocks)
    return jnp.moveaxis(o, 0, 1).reshape(b, s, D_QB)


def token_mixing(u, w_in, q_norm_a, k_norm_a, q_norm_b, k_norm_b,
                 w_branch_a, w_branch_b, w_out, cos, sin, slopes):
    b, s, _ = u.shape
    proj = u @ w_in
    qa, ka, va, qb, kb, vb, ga, gb = jnp.split(proj, SPLIT_POINTS, axis=-1)
    qa = rms_norm(qa.reshape(b, s, N_DIL_GROUPS, HEADS_PER_DIL, HEAD_DIM), q_norm_a)
    ka = rms_norm(ka.reshape(b, s, N_DIL_GROUPS, HEADS_PER_DIL, HEAD_DIM), k_norm_a)
    va = va.reshape(b, s, N_DIL_GROUPS, HEADS_PER_DIL, HEAD_DIM)
    out_a = dilated_attention(qa, ka, va, slopes)
    qb = apply_rope(rms_norm(qb.reshape(b, s, N_Q_B, HEAD_DIM), q_norm_b), cos, sin)
    kb = apply_rope(rms_norm(kb.reshape(b, s, N_KV_B, HEAD_DIM), k_norm_b), cos, sin)
    vb = vb.reshape(b, s, N_KV_B, HEAD_DIM)
    out_b = gqa_attention(qb.reshape(b, s, N_KV_B, Q_PER_KV, HEAD_DIM), kb, vb)
    merged = jax.nn.sigmoid(ga) * (out_a @ w_branch_a) + jax.nn.sigmoid(gb) * (out_b @ w_branch_b)
    return merged @ w_out


def setup_inputs(seed: int = 0) -> dict:
    key = jax.random.key(seed)
    ks = jax.random.split(key, 24)
    f32 = jnp.float32

    def dense(k, shape, fan_in, mult=1.0):
        return jax.random.normal(k, shape, f32) * (mult * fan_in ** -0.5)

    def gain(k, shape):
        return 1.0 + 0.02 * jax.random.normal(k, shape, f32)

    L = DEPTH
    return {
        "x": jax.random.normal(ks[0], (BATCH, SEQ, D_MODEL), f32),
        "c": jax.random.normal(ks[1], (BATCH, D_MODEL), f32),
        "w_ada": dense(ks[2], (L, D_MODEL, N_MOD * D_MODEL), D_MODEL, 0.5),
        "b_ada": 0.01 * jax.random.normal(ks[3], (L, N_MOD * D_MODEL), f32),
        "norm_ffn1": gain(ks[4], (L, D_MODEL)),
        "w1_ffn1": dense(ks[5], (L, D_MODEL, D_FF), D_MODEL),
        "w3_ffn1": dense(ks[6], (L, D_MODEL, D_FF), D_MODEL),
        "w2_ffn1": dense(ks[7], (L, D_FF, D_MODEL), D_FF),
        "norm_mix": gain(ks[8], (L, D_MODEL)),
        "w_in": dense(ks[9], (L, D_MODEL, D_IN), D_MODEL),
        "q_norm_a": gain(ks[10], (L, HEAD_DIM)),
        "k_norm_a": gain(ks[11], (L, HEAD_DIM)),
        "q_norm_b": gain(ks[12], (L, HEAD_DIM)),
        "k_norm_b": gain(ks[13], (L, HEAD_DIM)),
        "w_branch_a": dense(ks[14], (L, D_A_OUT, D_MODEL), D_A_OUT),
        "w_branch_b": dense(ks[15], (L, D_QB, D_MODEL), D_QB),
        "w_out": dense(ks[16], (L, D_MODEL, D_MODEL), D_MODEL),
        "norm_ffn2": gain(ks[17], (L, D_MODEL)),
        "w1_ffn2": dense(ks[18], (L, D_MODEL, D_FF), D_MODEL),
        "w3_ffn2": dense(ks[19], (L, D_MODEL, D_FF), D_MODEL),
        "w2_ffn2": dense(ks[20], (L, D_FF, D_MODEL), D_FF),
        "norm_final": gain(ks[21], (D_MODEL,)),
    }


def reference(x, c, w_ada, b_ada, norm_ffn1, w1_ffn1, w3_ffn1, w2_ffn1, norm_mix, w_in,
              q_norm_a, k_norm_a, q_norm_b, k_norm_b, w_branch_a, w_branch_b, w_out,
              norm_ffn2, w1_ffn2, w3_ffn2, w2_ffn2, norm_final):
    s = x.shape[1]
    cos, sin = axial_rope_tables(s)
    slopes = jnp.exp2(-ALIBI_MAX * jnp.arange(1, N_HEADS_A + 1, dtype=jnp.float32) / N_HEADS_A)
    slopes = slopes.reshape(N_DIL_GROUPS, HEADS_PER_DIL)
    c_act = jax.nn.silu(c)
    h = x
    for l in range(DEPTH):
        mod = c_act @ w_ada[l] + b_ada[l]
        sh1, sc1, g1, sh2, sc2, g2, sh3, sc3, g3 = jnp.split(mod, N_MOD, axis=-1)
        u = modulate(rms_norm(h, norm_ffn1[l]), sh1, sc1)
        h = h + 0.5 * g1[:, None, :] * swiglu(u, w1_ffn1[l], w3_ffn1[l], w2_ffn1[l])
        u = modulate(rms_norm(h, norm_mix[l]), sh2, sc2)
        h = h + g2[:, None, :] * token_mixing(u, w_in[l], q_norm_a[l], k_norm_a[l], q_norm_b[l],
                                              k_norm_b[l], w_branch_a[l], w_branch_b[l], w_out[l],
                                              cos, sin, slopes)
        u = modulate(rms_norm(h, norm_ffn2[l]), sh3, sc3)
        h = h + 0.5 * g3[:, None, :] * swiglu(u, w1_ffn2[l], w3_ffn2[l], w2_ffn2[l])
    return rms_norm(h, norm_final)
```

```cpp
#include <hip/hip_runtime.h>
#include <hip/hip_bf16.h>
#include <hip/hip_cooperative_groups.h>
#include <cstdio>
#include <cstdint>
namespace cg = cooperative_groups;

__device__ __forceinline__ int otid() { int t = threadIdx.x; asm volatile("" : "+v"(t)); return t; }
__device__ __forceinline__ int obid() { int b = blockIdx.x; asm volatile("" : "+s"(b)); return b; }

namespace pg8 {
#define PG8_LAS __attribute__((address_space(3)))
typedef unsigned short bf16_t;
typedef short bf16x8 __attribute__((ext_vector_type(8)));
typedef float f32x4 __attribute__((ext_vector_type(4)));
typedef unsigned u32x4 __attribute__((ext_vector_type(4)));
constexpr int BM = 256, BK = 64, HALF = 128, HTB = HALF * BK * 2  , STAGE_BYTES = 8 * HTB, NXCD = 8, WGM = 8;

__host__ __device__ __forceinline__ int lds_byte(int r, int c) { const int st = (r >> 4) * 2 + (c >> 5), rr = r & 15, cc = c & 31, ob = rr * 64 + cc * 2; return st * 1024 + (ob ^ (((ob >> 9) & 1) << 5)); }
__host__ __device__ __forceinline__ void stage_rc(int b, int& R, int& C) { const int st = b / 1024, sb = b % 1024, swz = sb ^ (((sb >> 9) & 1) << 5); R = (st >> 1) * 16 + swz / 64; C = (st & 1) * 32 + (swz % 64) / 2; }
__host__ __device__ __forceinline__ int perm32(int rho) { const int n = rho >> 4, i = rho & 15; return 8 * (i >> 2) + 4 * n + (i & 3); }

struct Unit { int pm, pn; };
struct Gemm { const bf16_t* A; const bf16_t* Bt; int M, N, K; };

struct StaticOrder {
    int nM, nN, nwg, G, c;
    __host__ __device__ void init(int M, int N, int G_, int c_) { nM = M / BM; nN = N / BM; nwg = nM * nN; G = G_; c = c_; }
    __host__ __device__ bool next(int i, Unit& u) const {
        const long L = (long)i * G + c; if (L >= nwg) return false;
        int wgid = (int)L; { const int q = nwg / NXCD, r = nwg % NXCD, xcd = wgid % NXCD, off = wgid / NXCD; wgid = (xcd < r ? xcd * (q + 1) : r * (q + 1) + (xcd - r) * q) + off; }
        const int nig = WGM * nN, gid = wgid / nig, fm = gid * WGM, gsz = (nM - fm) < WGM ? (nM - fm) : WGM;
        u.pm = fm + ((wgid % nig) % gsz); u.pn = (wgid % nig) / gsz; return true;
    }
    __device__ __forceinline__ void a_ready(const Unit&) const {}
    __device__ __forceinline__ void done(const Unit&) const {}
};

__device__ __forceinline__ unsigned cvt_pk_bf16(float lo, float hi) { unsigned r; asm volatile("v_cvt_pk_bf16_f32 %0, %1, %2" : "=v"(r) : "v"(lo), "v"(hi)); return r; }
typedef float f32x2 __attribute__((ext_vector_type(2)));
__device__ __forceinline__ float bf_lo(unsigned w) { return __uint_as_float(w << 16); }
__device__ __forceinline__ float bf_hi(unsigned w) { return __uint_as_float(w & 0xffff0000u); }
__device__ __forceinline__ float sigmoid_f(float v) { return __builtin_amdgcn_rcpf(1.f + __builtin_amdgcn_exp2f(-1.4426950408889634f * v)); }

struct EpiSwiGLU {
    static constexpr bool PERM = true, AFTER_DRAIN = false;
    bf16_t* O; int ldc;
    __device__ __forceinline__ void operator()(const f32x4 (&acc)[2][2][4][2], const Unit& u, int wr, int wc, int fr, int fq) const {
        const int row0 = u.pm * BM + wr * 64 + fr, col0 = u.pn * HALF + wc * 32 + 8 * fq;
#pragma unroll
        for (int ai = 0; ai < 2; ++ai)
#pragma unroll
            for (int m = 0; m < 4; ++m) {
                bf16_t* rowp = O + (size_t)(row0 + ai * HALF + m * 16) * ldc + col0;
                float v[8];
#pragma unroll
                for (int n = 0; n < 2; ++n)
#pragma unroll
                    for (int j = 0; j < 4; ++j) { const float g = acc[ai][0][m][n][j], up = acc[ai][1][m][n][j]; v[n * 4 + j] = g * sigmoid_f(g) * up; }
                u32x4 w; w.x = cvt_pk_bf16(v[0], v[1]); w.y = cvt_pk_bf16(v[2], v[3]); w.z = cvt_pk_bf16(v[4], v[5]); w.w = cvt_pk_bf16(v[6], v[7]);
                *(u32x4*)rowp = w;
            }
    }
};
struct EpiResid {
    static constexpr bool PERM = true, AFTER_DRAIN = false;
    const float* hin; float* hout; const float* gate; float coef;
    __device__ __forceinline__ void operator()(const f32x4 (&acc)[2][2][4][2], const Unit& u, int wr, int wc, int fr, int fq) const {
        const int row0 = u.pm * BM + wr * 64 + fr, col0 = u.pn * BM + wc * 32 + 8 * fq;
        const float* gp = gate + (size_t)((u.pm * BM) >> 13) * 18432 + col0;
        f32x4 gv[2][2];
#pragma unroll
        for (int bj = 0; bj < 2; ++bj)
#pragma unroll
            for (int n = 0; n < 2; ++n) gv[bj][n] = *(const f32x4*)(gp + bj * HALF + 4 * n) * coef;
#pragma unroll
        for (int ai = 0; ai < 2; ++ai) {
            f32x4 hv[4][2][2];
#pragma unroll
            for (int m = 0; m < 4; ++m)
#pragma unroll
                for (int bj = 0; bj < 2; ++bj)
#pragma unroll
                    for (int n = 0; n < 2; ++n) hv[m][bj][n] = *(const f32x4*)(hin + (size_t)(row0 + ai * HALF + m * 16) * 2048 + col0 + bj * HALF + 4 * n);
            asm volatile("" ::: "memory");
#pragma unroll
            for (int m = 0; m < 4; ++m)
#pragma unroll
                for (int bj = 0; bj < 2; ++bj)
#pragma unroll
                    for (int n = 0; n < 2; ++n) *(f32x4*)(hout + (size_t)(row0 + ai * HALF + m * 16) * 2048 + col0 + bj * HALF + 4 * n) = hv[m][bj][n] + gv[bj][n] * acc[ai][bj][m][n];
            asm volatile("" ::: "memory");
        }
    }
};
struct EpiDelta {
    static constexpr bool PERM = true, AFTER_DRAIN = false;
    bf16_t* D; const float* gate; float coef;
    __device__ __forceinline__ void operator()(const f32x4 (&acc)[2][2][4][2], const Unit& u, int wr, int wc, int fr, int fq) const {
        const int row0 = u.pm * BM + wr * 64 + fr, col0 = u.pn * BM + wc * 32 + 8 * fq;
        const float* gp = gate + (size_t)((u.pm * BM) >> 13) * 18432 + col0;
        f32x4 gv[2][2];
#pragma unroll
        for (int bj = 0; bj < 2; ++bj)
#pragma unroll
            for (int n = 0; n < 2; ++n) gv[bj][n] = *(const f32x4*)(gp + bj * HALF + 4 * n) * coef;
#pragma unroll
        for (int ai = 0; ai < 2; ++ai)
#pragma unroll
            for (int m = 0; m < 4; ++m) {
                bf16_t* rowp = D + (size_t)(row0 + ai * HALF + m * 16) * 2048 + col0;
#pragma unroll
                for (int bj = 0; bj < 2; ++bj) {
                    const f32x4 v0 = acc[ai][bj][m][0] * gv[bj][0], v1 = acc[ai][bj][m][1] * gv[bj][1];
                    u32x4 w; w.x = cvt_pk_bf16(v0[0], v0[1]); w.y = cvt_pk_bf16(v0[2], v0[3]); w.z = cvt_pk_bf16(v1[0], v1[1]); w.w = cvt_pk_bf16(v1[2], v1[3]);
                    *(u32x4*)(rowp + bj * HALF) = w;
                }
            }
    }
};
struct EpiProj {
    static constexpr bool PERM = true, AFTER_DRAIN = false;
    bf16_t* O; int ldc;
    __device__ __forceinline__ void operator()(const f32x4 (&acc)[2][2][4][2], const Unit& u, int wr, int wc, int fr, int fq) const {
        const int row0 = u.pm * BM + wr * 64 + fr, col0 = u.pn * BM + wc * 32 + 8 * fq;
#pragma unroll
        for (int ai = 0; ai < 2; ++ai)
#pragma unroll
            for (int m = 0; m < 4; ++m) {
                bf16_t* rowp = O + (size_t)(row0 + ai * HALF + m * 16) * ldc + col0;
#pragma unroll
                for (int bj = 0; bj < 2; ++bj) {
                    const f32x4 v0 = acc[ai][bj][m][0], v1 = acc[ai][bj][m][1];
                    u32x4 w; w.x = cvt_pk_bf16(v0[0], v0[1]); w.y = cvt_pk_bf16(v0[2], v0[3]); w.z = cvt_pk_bf16(v1[0], v1[1]); w.w = cvt_pk_bf16(v1[2], v1[3]);
                    *(u32x4*)(rowp + bj * HALF) = w;
                }
            }
    }
};
template <bool ADD> struct EpiGate {
    static constexpr bool PERM = true, AFTER_DRAIN = false;
    bf16_t* T; const bf16_t* G; int ldg;
    __device__ __forceinline__ void operator()(const f32x4 (&acc)[2][2][4][2], const Unit& u, int wr, int wc, int fr, int fq) const {
        const int row0 = u.pm * BM + wr * 64 + fr, col0 = u.pn * BM + wc * 32 + 8 * fq;
#pragma unroll
        for (int ai = 0; ai < 2; ++ai) {
            u32x4 gw[4][2], tw[4][2];
#pragma unroll
            for (int m = 0; m < 4; ++m)
#pragma unroll
                for (int bj = 0; bj < 2; ++bj) { const size_t row = (size_t)(row0 + ai * HALF + m * 16);
                    gw[m][bj] = *(const u32x4*)(G + row * ldg + col0 + bj * HALF);
                    if (ADD) tw[m][bj] = *(const u32x4*)(T + row * 2048 + col0 + bj * HALF); }
            asm volatile("" ::: "memory");
#pragma unroll
            for (int m = 0; m < 4; ++m)
#pragma unroll
                for (int bj = 0; bj < 2; ++bj) { const size_t row = (size_t)(row0 + ai * HALF + m * 16);
                    bf16_t* tp = T + row * 2048 + col0 + bj * HALF;
                    const f32x4 v0 = acc[ai][bj][m][0], v1 = acc[ai][bj][m][1]; const u32x4 g4 = gw[m][bj];
                    float r[8];
                    r[0] = sigmoid_f(bf_lo(g4.x)) * v0[0]; r[1] = sigmoid_f(bf_hi(g4.x)) * v0[1]; r[2] = sigmoid_f(bf_lo(g4.y)) * v0[2]; r[3] = sigmoid_f(bf_hi(g4.y)) * v0[3];
                    r[4] = sigmoid_f(bf_lo(g4.z)) * v1[0]; r[5] = sigmoid_f(bf_hi(g4.z)) * v1[1]; r[6] = sigmoid_f(bf_lo(g4.w)) * v1[2]; r[7] = sigmoid_f(bf_hi(g4.w)) * v1[3];
                    if (ADD) { const u32x4 t4 = tw[m][bj];
                        r[0] += bf_lo(t4.x); r[1] += bf_hi(t4.x); r[2] += bf_lo(t4.y); r[3] += bf_hi(t4.y); r[4] += bf_lo(t4.z); r[5] += bf_hi(t4.z); r[6] += bf_lo(t4.w); r[7] += bf_hi(t4.w); }
                    u32x4 w; w.x = cvt_pk_bf16(r[0], r[1]); w.y = cvt_pk_bf16(r[2], r[3]); w.z = cvt_pk_bf16(r[4], r[5]); w.w = cvt_pk_bf16(r[6], r[7]);
                    *(u32x4*)tp = w; }
            asm volatile("" ::: "memory");
        }
    }
};
template <class Epi, class Sched, bool ALIGN_EPI = false, bool SP2 = false>
__device__ __forceinline__ void gemm_phase(PG8_LAS unsigned char* lds, const Gemm g, const Sched& S, const Epi& E) {
    const int tid = otid(), wid = __builtin_amdgcn_readfirstlane(tid >> 6), lane = tid & 63, wr = wid >> 2, wc = wid & 3, fr = lane & 15, fq = lane >> 4;
    const int K = g.K, nt = K / BK;
    unsigned voffA[2], voffB[2];
#pragma unroll
    for (int i = 0; i < 2; ++i) { int R, C; stage_rc(tid * 16 + i * 8192, R, C); const int Rb = Epi::PERM ? ((R & ~31) + perm32(R & 31)) : R;
        voffA[i] = (unsigned)(R * K + C) * 2u; voffB[i] = (unsigned)(Rb * K + C) * 2u; }
    const size_t kstep = (size_t)(BK * 2);
    const size_t hstep = (size_t)HALF * K * 2;
    const size_t tstep = 2 * hstep;
    const unsigned ldsw = (unsigned)wid * 1024u;
    const int aoff = lds_byte(wr * 64 + fr, fq * 8), boff = lds_byte(wc * 32 + fr, fq * 8);
#define PG8_SA(b, h) (((b) * 2 + (h)) * HTB)
#define PG8_SB(b, h) ((4 + (b) * 2 + (h)) * HTB)
#define PG8_STAGE(bufoff, gbase, voff) do { _Pragma("unroll") for (int _i = 0; _i < 2; ++_i) \
        __builtin_amdgcn_global_load_lds((const unsigned*)((const char*)(gbase) + (voff)[_i]), (PG8_LAS unsigned*)(lds + (bufoff) + ldsw + _i * 8192), 16, 0, 0); } while (0)
#define PG8_LDA(dst, b, h) do { _Pragma("unroll") for (int m = 0; m < 4; ++m) _Pragma("unroll") for (int k = 0; k < 2; ++k) dst[m][k] = *(const PG8_LAS bf16x8*)(lds + PG8_SA(b, h) + aoff + m * 2048 + k * 1024); } while (0)
#define PG8_LDB(dst, b, h) do { _Pragma("unroll") for (int n = 0; n < 2; ++n) _Pragma("unroll") for (int k = 0; k < 2; ++k) dst[n][k] = *(const PG8_LAS bf16x8*)(lds + PG8_SB(b, h) + boff + n * 2048 + k * 1024); } while (0)
#define PG8_MMA(ai, bj, At, Bt) do { __builtin_amdgcn_s_setprio(1); _Pragma("unroll") for (int m = 0; m < 4; ++m) _Pragma("unroll") for (int n = 0; n < 2; ++n) _Pragma("unroll") for (int k = 0; k < 2; ++k) \
        acc[ai][bj][m][n] = __builtin_amdgcn_mfma_f32_16x16x32_bf16(Bt[n][k], At[m][k], acc[ai][bj][m][n], 0, 0, 0); __builtin_amdgcn_s_setprio(0); } while (0)
#define PG8_WAIT_V(n) asm volatile("s_waitcnt vmcnt(" #n ")" ::: "memory")
#define PG8_WAIT_L(n) asm volatile("s_waitcnt lgkmcnt(" #n ")" ::: "memory")
#define PG8_BAR __builtin_amdgcn_s_barrier()
#define PG8_SCHED __builtin_amdgcn_sched_barrier(0)
    Unit cur, nxt; int ui = 0;
    if (!S.next(0, cur)) return;
    f32x4 acc[2][2][4][2];
#pragma unroll
    for (int a = 0; a < 2; ++a)
#pragma unroll
        for (int b = 0; b < 2; ++b)
#pragma unroll
            for (int m = 0; m < 4; ++m)
#pragma unroll
                for (int n = 0; n < 2; ++n) acc[a][b][m][n] = (f32x4){0.f, 0.f, 0.f, 0.f};
    bf16x8 At[4][2], B0[2][2], B1[2][2];
    const char* cA = (const char*)g.A + (size_t)cur.pm * tstep; const char* cB = (const char*)g.Bt + (size_t)cur.pn * tstep;
    S.a_ready(cur);
    if constexpr (SP2) {
        PG8_STAGE(PG8_SB(0, 0), cB, voffB); PG8_STAGE(PG8_SB(0, 1), cB + hstep, voffB); PG8_STAGE(PG8_SA(0, 0), cA, voffA); PG8_STAGE(PG8_SA(0, 1), cA + hstep, voffA);
        if (wr == 1) PG8_BAR;
        PG8_WAIT_V(2); PG8_BAR;
        PG8_STAGE(PG8_SB(1, 0), cB + kstep, voffB); PG8_STAGE(PG8_SA(1, 0), cA + kstep, voffA); PG8_STAGE(PG8_SB(1, 1), cB + hstep + kstep, voffB);
        PG8_WAIT_V(6); PG8_BAR;
    } else {
        PG8_STAGE(PG8_SB(0, 0), cB, voffB); PG8_STAGE(PG8_SA(0, 0), cA, voffA); PG8_STAGE(PG8_SB(0, 1), cB + hstep, voffB); PG8_STAGE(PG8_SA(0, 1), cA + hstep, voffA);
        if (wr == 1) PG8_BAR;
        PG8_WAIT_V(4); PG8_BAR;
        PG8_STAGE(PG8_SB(1, 0), cB + kstep, voffB); PG8_STAGE(PG8_SA(1, 0), cA + kstep, voffA); PG8_STAGE(PG8_SB(1, 1), cB + hstep + kstep, voffB);
        PG8_WAIT_V(6); PG8_BAR;
    }
    for (;;) {
        const bool has_next = S.next(ui + 1, nxt);
        const char* nA = has_next ? (const char*)g.A + (size_t)nxt.pm * tstep : cA; const char* nB = has_next ? (const char*)g.Bt + (size_t)nxt.pn * tstep : cB;
        for (int t = 0; t < nt; t += 2) {
            const bool last = (t == nt - 2);
            const char* a1 = cA + (size_t)(t + 1) * kstep;
            const char* a2 = last ? nA : cA + (size_t)(t + 2) * kstep; const char* b2 = last ? nB : cB + (size_t)(t + 2) * kstep;
            const char* a3 = a2 + kstep; const char* b3 = b2 + kstep;
            if (last && has_next) S.a_ready(nxt);
            if constexpr (SP2) {
            PG8_LDB(B0, 0, 0); PG8_LDB(B1, 0, 1); PG8_SCHED; PG8_LDA(At, 0, 0); PG8_STAGE(PG8_SA(1, 1), a1 + hstep, voffA);
            PG8_WAIT_V(8); PG8_WAIT_L(0); PG8_BAR; PG8_MMA(0, 0, At, B0); PG8_MMA(0, 1, At, B1); PG8_BAR; PG8_SCHED;
            PG8_LDA(At, 0, 1); PG8_STAGE(PG8_SB(0, 0), b2, voffB); PG8_STAGE(PG8_SB(0, 1), b2 + hstep, voffB); PG8_STAGE(PG8_SA(0, 0), a2, voffA);
            PG8_WAIT_V(8); PG8_WAIT_L(0); PG8_BAR; PG8_MMA(1, 0, At, B0); PG8_MMA(1, 1, At, B1); PG8_BAR; PG8_SCHED;
            PG8_LDB(B0, 1, 0); PG8_LDB(B1, 1, 1); PG8_SCHED; PG8_LDA(At, 1, 0); PG8_STAGE(PG8_SA(0, 1), a2 + hstep, voffA);
            PG8_WAIT_V(8); PG8_WAIT_L(0); PG8_BAR; PG8_MMA(0, 0, At, B0); PG8_MMA(0, 1, At, B1); PG8_BAR; PG8_SCHED;
            PG8_LDA(At, 1, 1); PG8_STAGE(PG8_SB(1, 0), b3, voffB); PG8_STAGE(PG8_SB(1, 1), b3 + hstep, voffB); PG8_STAGE(PG8_SA(1, 0), a3, voffA);
            PG8_WAIT_V(8); PG8_WAIT_L(0); PG8_BAR; PG8_MMA(1, 0, At, B0); PG8_MMA(1, 1, At, B1); PG8_BAR; PG8_SCHED;
            } else {
            PG8_LDB(B0, 0, 0); PG8_SCHED; PG8_LDA(At, 0, 0); PG8_STAGE(PG8_SA(1, 1), a1 + hstep, voffA);
            PG8_WAIT_L(8); PG8_BAR; PG8_WAIT_L(0); PG8_MMA(0, 0, At, B0); PG8_BAR; PG8_SCHED;
            PG8_LDB(B1, 0, 1); PG8_STAGE(PG8_SB(0, 0), b2, voffB);
            PG8_BAR; PG8_WAIT_L(0); PG8_MMA(0, 1, At, B1); PG8_BAR;
            PG8_LDA(At, 0, 1); PG8_STAGE(PG8_SA(0, 0), a2, voffA);
            PG8_BAR; PG8_WAIT_L(0); PG8_MMA(1, 0, At, B0); PG8_BAR; PG8_SCHED;
            PG8_STAGE(PG8_SB(0, 1), b2 + hstep, voffB);
            PG8_WAIT_V(6); PG8_BAR; PG8_MMA(1, 1, At, B1); PG8_BAR;
            PG8_LDB(B0, 1, 0); PG8_SCHED; PG8_LDA(At, 1, 0); PG8_STAGE(PG8_SA(0, 1), a2 + hstep, voffA);
            PG8_WAIT_L(8); PG8_BAR; PG8_WAIT_L(0); PG8_MMA(0, 0, At, B0); PG8_BAR; PG8_SCHED;
            PG8_LDB(B1, 1, 1); PG8_STAGE(PG8_SB(1, 0), b3, voffB);
            PG8_BAR; PG8_WAIT_L(0); PG8_MMA(0, 1, At, B1); PG8_BAR;
            PG8_LDA(At, 1, 1); PG8_STAGE(PG8_SA(1, 0), a3, voffA);
            PG8_BAR; PG8_WAIT_L(0); PG8_MMA(1, 0, At, B0); PG8_BAR; PG8_SCHED;
            PG8_STAGE(PG8_SB(1, 1), b3 + hstep, voffB);
            PG8_WAIT_V(6); PG8_BAR; PG8_MMA(1, 1, At, B1); PG8_BAR;
            }
        }
        if constexpr (ALIGN_EPI) { if (wr == 0) PG8_BAR; }
        if constexpr (!Epi::AFTER_DRAIN) { E(acc, cur, wr, wc, fr, fq); S.done(cur); }
        if (!has_next) break;
#pragma unroll
        for (int a = 0; a < 2; ++a)
#pragma unroll
            for (int b = 0; b < 2; ++b)
#pragma unroll
                for (int m = 0; m < 4; ++m)
#pragma unroll
                    for (int n = 0; n < 2; ++n) acc[a][b][m][n] = (f32x4){0.f, 0.f, 0.f, 0.f};
        cur = nxt; cA = nA; cB = nB; ++ui;
        if constexpr (ALIGN_EPI) { if (wr == 1) PG8_BAR; }
    }
    PG8_WAIT_V(0);
    if constexpr (!ALIGN_EPI) { if (wr == 0) PG8_BAR; }
    PG8_BAR;
    if constexpr (Epi::AFTER_DRAIN) { E.fused(acc, cur, wr, wc, fr, fq, lds, wid, lane); S.done(cur); }
#undef PG8_SA
#undef PG8_SB
#undef PG8_STAGE
#undef PG8_LDA
#undef PG8_LDB
#undef PG8_MMA
#undef PG8_WAIT_V
#undef PG8_WAIT_L
#undef PG8_BAR
#undef PG8_SCHED
}
}

#define LAS __attribute__((address_space(3)))
typedef unsigned short bf16_t;
using bf16x8 = __attribute__((ext_vector_type(8))) short;
using s16x4  = __attribute__((ext_vector_type(4))) short;
using f32x16 = __attribute__((ext_vector_type(16))) float;
using f32x4  = __attribute__((ext_vector_type(4))) float;
using u32x4  = __attribute__((ext_vector_type(4))) unsigned;
using u32x2  = __attribute__((ext_vector_type(2))) unsigned;

constexpr int DM = 2048, SEQ = 8192, NBATCH = 2, MTOK = 16384, DFF = 5632, DIN = 10240, NMOD = 18432;
constexpr int OFF_QA = 0, OFF_KA = 1536, OFF_VA = 3072, OFF_QB = 4608, OFF_KB = 5632, OFF_VB = 5888, OFF_GA = 6144, OFF_GB = 8192;
constexpr float EPS = 1e-6f;
constexpr int NTHREADS = 512, LDS_BYTES = 136 * 1024;
constexpr size_t SZ_W13 = (size_t)2 * DFF * DM * 2, SZ_W2 = (size_t)DM * DFF * 2, SZ_WIN = (size_t)DIN * DM * 2, SZ_WBA = (size_t)DM * 512 * 2, SZ_WBB = (size_t)DM * 1024 * 2, SZ_WOUT = (size_t)DM * DM * 2;
constexpr size_t WS_W13_1 = 0, WS_W2_1 = WS_W13_1 + SZ_W13, WS_WIN = WS_W2_1 + SZ_W2, WS_WBA = WS_WIN + SZ_WIN, WS_WBB = WS_WBA + SZ_WBA, WS_WOUT = WS_WBB + SZ_WBB,
                 WS_W13_2 = WS_WOUT + SZ_WOUT, WS_W2_2 = WS_W13_2 + SZ_W13, WS_MOD = WS_W2_2 + SZ_W2, WS_CS = WS_MOD + (size_t)NBATCH * NMOD * 4, WS_LSE = WS_CS + 128 * 32 * 8,
                 WS_H16 = WS_LSE + (size_t)3 * MTOK * 4 * 4, WS_U = WS_H16 + (size_t)MTOK * DM * 2, WS_P = WS_U + (size_t)MTOK * DM * 2, WS_BAR = WS_P + (size_t)MTOK * DIN * 2, WS_END = WS_BAR + 16384;
constexpr size_t WS_OUTA = WS_W13_1, WS_OUTB = WS_OUTA + (size_t)MTOK * 512 * 2;
constexpr size_t WS_KBC = WS_OUTB + (size_t)MTOK * 1024 * 2, WS_VBC = WS_KBC + (size_t)MTOK * 256 * 2;
static_assert(WS_VBC + (size_t)MTOK * 256 * 2 <= WS_WIN, "overlay");
constexpr size_t WS_D2 = WS_W13_1;
static_assert(WS_D2 + (size_t)MTOK * DM * 2 <= WS_WIN, "overlay");

struct Params { const float* in[22]; float* out; unsigned char* ws; int ph_lo, ph_hi; };

__device__ __forceinline__ unsigned cvtpk(float lo, float hi) { unsigned r; asm volatile("v_cvt_pk_bf16_f32 %0, %1, %2" : "=v"(r) : "v"(lo), "v"(hi)); return r; }
__device__ __forceinline__ float bflo(unsigned w) { return __uint_as_float(w << 16); }
__device__ __forceinline__ float bfhi(unsigned w) { return __uint_as_float(w & 0xffff0000u); }
typedef _Float16 h16x2 __attribute__((ext_vector_type(2)));
__device__ __forceinline__ unsigned pkh(float a, float b) { h16x2 v = {(_Float16)a, (_Float16)b}; return __builtin_bit_cast(unsigned, v); }
__device__ __forceinline__ float h2f(unsigned h) { const float m = __uint_as_float((h & 0x7fffu) << 13) * 0x1p112f; return __uint_as_float(__float_as_uint(m) | ((h & 0x8000u) << 16)); }
__device__ __forceinline__ f32x4 unpk_h4(u32x2 w) { return (f32x4){h2f(w.x & 0xffffu), h2f(w.x >> 16), h2f(w.y & 0xffffu), h2f(w.y >> 16)}; }
__device__ __forceinline__ f32x4 unpk_b4(u32x2 w) { return (f32x4){bflo(w.x), bfhi(w.x), bflo(w.y), bfhi(w.y)}; }
__device__ __forceinline__ float wave_sum(float v) {
#pragma unroll
    for (int o = 1; o < 64; o <<= 1) v += __shfl_xor(v, o);
    return v;
}

constexpr int D = 128, NW = 8, QBLK = 32, KVBLK = 64;
constexpr float SCALE = 0.088388347648318440f;
constexpr float THR = 8.f;
constexpr int LDQ = DIN, LDK = 128, LDO = 1024;
constexpr size_t SHM_V = KVBLK * D * 2, SHM_K = KVBLK * D * 2, SHM_ATTN = 2 * SHM_V + 2 * SHM_K + NW * 64 * 4;
#define KSWZ(row, colB) ((row) * 256 + ((colB) ^ (((row) & 7) << 4)))
#define SBAR() __builtin_amdgcn_sched_barrier(0)
__device__ __forceinline__ int crow(int r, int hi) { return (r & 3) + 8 * (r >> 2) + 4 * hi; }

__device__ __forceinline__ void partialSM(f32x16& p0, f32x16& p1, float& m_reg, float& mn, float& alpha) {
  constexpr float C = SCALE * 1.4426950408889634f;
  float pmax = p0[0];
#pragma unroll
  for (int r = 1; r < 16; ++r) pmax = fmaxf(pmax, p0[r]);
#pragma unroll
  for (int r = 0; r < 16; ++r) pmax = fmaxf(pmax, p1[r]);
  { auto rr = __builtin_amdgcn_permlane32_swap(__float_as_uint(pmax), __float_as_uint(pmax), false, false);
    pmax = fmaxf(__uint_as_float(rr[0]), __uint_as_float(rr[1])); }
  if (__builtin_expect(__all(pmax - m_reg <= THR / SCALE), 1)) { mn = m_reg; alpha = 1.f; }
  else { mn = fmaxf(m_reg, pmax); alpha = __builtin_amdgcn_exp2f((m_reg - mn) * C); m_reg = mn; }
  float mnC = -mn * C;
#pragma unroll
  for (int r = 0; r < 16; ++r) p0[r] = fmaf(p0[r], C, mnC);
#pragma unroll
  for (int r = 0; r < 16; ++r) p1[r] = fmaf(p1[r], C, mnC);
#pragma unroll
  for (int r = 0; r < 16; ++r) p0[r] = __builtin_amdgcn_exp2f(p0[r]);
}
__device__ __forceinline__ void finishSM(f32x16& p0, f32x16& p1, float alpha, float& l_reg, bf16x8& pa0, bf16x8& pa1, bf16x8& pa2, bf16x8& pa3) {
#pragma unroll
  for (int r = 0; r < 16; ++r) p1[r] = __builtin_amdgcn_exp2f(p1[r]);
  float ps = 0;
#pragma unroll
  for (int r = 0; r < 16; ++r) ps += p0[r];
#pragma unroll
  for (int r = 0; r < 16; ++r) ps += p1[r];
  { auto rr = __builtin_amdgcn_permlane32_swap(__float_as_uint(ps), __float_as_uint(ps), false, false);
    ps = __uint_as_float(rr[0]) + __uint_as_float(rr[1]); }
  l_reg = l_reg * alpha + ps;
#define PK4(P, BASE, OUT) do { unsigned a0 = cvtpk(P[BASE + 0], P[BASE + 1]), a1 = cvtpk(P[BASE + 2], P[BASE + 3]);   \
    unsigned b0 = cvtpk(P[BASE + 4], P[BASE + 5]), b1 = cvtpk(P[BASE + 6], P[BASE + 7]);                              \
    auto r0 = __builtin_amdgcn_permlane32_swap(a0, b0, false, false); auto r1 = __builtin_amdgcn_permlane32_swap(a1, b1, false, false); \
    u32x4 w = {r0[0], r1[0], r0[1], r1[1]}; OUT = *reinterpret_cast<bf16x8*>(&w); } while (0)
  PK4(p0, 0, pa0); PK4(p0, 8, pa1); PK4(p1, 0, pa2); PK4(p1, 8, pa3);
#undef PK4
}
__device__ __forceinline__ void qkt(f32x16& p0, f32x16& p1, const bf16_t* Ks, const bf16x8* qr, int r32, int hi) {
  p0 = f32x16{}; p1 = f32x16{};
#pragma unroll
  for (int d0 = 0; d0 < 8; ++d0) { int cb = (d0 * 16 + hi * 8) * 2;
    bf16x8 b0 = *reinterpret_cast<const bf16x8*>((const char*)Ks + KSWZ(r32, cb));
    bf16x8 b1 = *reinterpret_cast<const bf16x8*>((const char*)Ks + KSWZ(32 + r32, cb));
    p0 = __builtin_amdgcn_mfma_f32_32x32x16_bf16(b0, qr[d0], p0, 0, 0, 0);
    p1 = __builtin_amdgcn_mfma_f32_32x32x16_bf16(b1, qr[d0], p1, 0, 0, 0); }
}
__device__ __forceinline__ int v_st(int k, int c) { const int kk = (k & ~0xC) | ((k & 4) << 1) | ((k & 8) >> 1); return ((kk >> 3) * 4 + (c >> 5)) * 512 + ((kk & 7) * 32 + (c & 31)) * 2; }
__device__ __forceinline__ int v_rd_base(int lane) { return ((lane & 3) << 3) | (((lane >> 2) & 3) << 6) | (((lane >> 4) & 1) << 5) | (((lane >> 5) & 1) << 8); }
constexpr int v_rd_off(int d0, int ks, int half) { return d0 * 512 + ks * 4096 + half * 2048; }
template <int OFF> __device__ __forceinline__ s16x4 tr_read(int vb) {
  s16x4 r; asm volatile("ds_read_b64_tr_b16 %0, %1 offset:%2" : "=&v"(r) : "v"(vb), "i"(OFF) : "memory"); return r;
}
template <int D0> __device__ __forceinline__ void pv_one(f32x16& od, int vb, bf16x8 pa0, bf16x8 pa1, bf16x8 pa2, bf16x8 pa3) {
  const s16x4 l0 = tr_read<v_rd_off(D0, 0, 0)>(vb), h0 = tr_read<v_rd_off(D0, 0, 1)>(vb), l1 = tr_read<v_rd_off(D0, 1, 0)>(vb), h1 = tr_read<v_rd_off(D0, 1, 1)>(vb);
  const s16x4 l2 = tr_read<v_rd_off(D0, 2, 0)>(vb), h2 = tr_read<v_rd_off(D0, 2, 1)>(vb), l3 = tr_read<v_rd_off(D0, 3, 0)>(vb), h3 = tr_read<v_rd_off(D0, 3, 1)>(vb);
  asm volatile("s_waitcnt lgkmcnt(0)" ::: "memory"); SBAR();
#define PK(L, H) (bf16x8){L[0], L[1], L[2], L[3], H[0], H[1], H[2], H[3]}
  od = __builtin_amdgcn_mfma_f32_32x32x16_bf16(pa0, PK(l0, h0), od, 0, 0, 0);
  od = __builtin_amdgcn_mfma_f32_32x32x16_bf16(pa1, PK(l1, h1), od, 0, 0, 0);
  od = __builtin_amdgcn_mfma_f32_32x32x16_bf16(pa2, PK(l2, h2), od, 0, 0, 0);
  od = __builtin_amdgcn_mfma_f32_32x32x16_bf16(pa3, PK(l3, h3), od, 0, 0, 0);
#undef PK
}
__device__ __forceinline__ void pv_d0(f32x16* o, int vb, bf16x8 pa0, bf16x8 pa1, bf16x8 pa2, bf16x8 pa3) {
  pv_one<0>(o[0], vb, pa0, pa1, pa2, pa3); pv_one<1>(o[1], vb, pa0, pa1, pa2, pa3); pv_one<2>(o[2], vb, pa0, pa1, pa2, pa3); pv_one<3>(o[3], vb, pa0, pa1, pa2, pa3);
}
#define PINF(x) asm volatile("" : "+v"(x))
#define PIN16(P) do { _Pragma("unroll") for (int r_ = 0; r_ < 16; ++r_) { float t_ = P[r_]; PINF(t_); P[r_] = t_; } } while (0)
__device__ __forceinline__ void pv_sm(f32x16* o, int vb, bf16x8 pa0, bf16x8 pa1, bf16x8 pa2, bf16x8 pa3, f32x16& p0, f32x16& p1, float& m_reg, float& mn, float& alpha) {
  constexpr float C = SCALE * 1.4426950408889634f;
  pv_one<0>(o[0], vb, pa0, pa1, pa2, pa3);
  float pmax = p0[0];
#pragma unroll
  for (int r = 1; r < 16; ++r) pmax = fmaxf(pmax, p0[r]);
  PINF(pmax);
  pv_one<1>(o[1], vb, pa0, pa1, pa2, pa3);
#pragma unroll
  for (int r = 0; r < 16; ++r) pmax = fmaxf(pmax, p1[r]);
  { auto rr = __builtin_amdgcn_permlane32_swap(__float_as_uint(pmax), __float_as_uint(pmax), false, false);
    pmax = fmaxf(__uint_as_float(rr[0]), __uint_as_float(rr[1])); }
  const bool keep = __all(pmax - m_reg <= THR / SCALE);
  const float mnew = fmaxf(m_reg, pmax);
  const float a2 = __builtin_amdgcn_exp2f((m_reg - mnew) * C);
  mn = keep ? m_reg : mnew; alpha = keep ? 1.f : a2; m_reg = mn;
  float mnC = -mn * C;
  PINF(mnC); PINF(alpha);
  pv_one<2>(o[2], vb, pa0, pa1, pa2, pa3);
#pragma unroll
  for (int r = 0; r < 16; ++r) p0[r] = fmaf(p0[r], C, mnC);
#pragma unroll
  for (int r = 0; r < 16; ++r) p1[r] = fmaf(p1[r], C, mnC);
  PIN16(p0); PIN16(p1);
  pv_one<3>(o[3], vb, pa0, pa1, pa2, pa3);
#pragma unroll
  for (int r = 0; r < 16; ++r) p0[r] = __builtin_amdgcn_exp2f(p0[r]);
  PIN16(p0);
  SBAR();
}
__device__ __forceinline__ bf16x8 ld8(const bf16_t* p) { return *reinterpret_cast<const bf16x8*>(p); }

__device__ __forceinline__ void attn_dense_body(const bf16_t* Qb, const bf16_t* Kh, const bf16_t* Vh, bf16_t* Ob, int seq, char* lds) {
  constexpr int SDEPTH = 2;
  const int tid = otid(), wid = tid >> 6, lane = tid & 63, r32 = lane & 31, hi = lane >> 5;
  bf16_t* V_lds = (bf16_t*)lds; bf16_t* K_lds = (bf16_t*)(lds + 2 * SHM_V);
  float* ws = (float*)(lds + 2 * SHM_V + 2 * SHM_K) + wid * 64; float* li_l = ws; float* al_l = ws + 32;
  float m_reg = -1e30f, l_reg = 0; f32x16 o[4] = {}; bf16x8 qr[8];
  const bf16_t* Qw = Qb + (long)(wid * QBLK + r32) * LDQ + hi * 8;
#pragma unroll
  for (int d0 = 0; d0 < 8; ++d0) qr[d0] = ld8(Qw + d0 * 16);
  const int sr = tid >> 4, sc = (tid & 15) * 8, vst0 = v_st(sr, sc), vst1 = v_st(32 + sr, sc);
  const int vb0 = (int)(uintptr_t)V_lds + v_rd_base(lane);
  struct { bf16x8 vs0, vs1, ks0, ks1; } sr_[SDEPTH];
#define SLOAD(i, k0) do { sr_[i].vs0 = ld8(&Vh[(long)((k0) + sr) * LDK + sc]); sr_[i].vs1 = ld8(&Vh[(long)((k0) + 32 + sr) * LDK + sc]); \
    sr_[i].ks0 = ld8(&Kh[(long)((k0) + sr) * LDK + sc]); sr_[i].ks1 = ld8(&Kh[(long)((k0) + 32 + sr) * LDK + sc]); } while (0)
#define SWRITE(b, i) do { *(bf16x8*)((char*)V_lds + (b) * SHM_V + vst0) = sr_[i].vs0;          \
    *(bf16x8*)((char*)V_lds + (b) * SHM_V + vst1) = sr_[i].vs1; int kc = sc * 2;               \
    *(bf16x8*)((char*)K_lds + (b) * SHM_K + KSWZ(sr, kc)) = sr_[i].ks0;                       \
    *(bf16x8*)((char*)K_lds + (b) * SHM_K + KSWZ(32 + sr, kc)) = sr_[i].ks1; } while (0)
#define SWAIT() asm volatile("s_waitcnt vmcnt(4)" ::: "memory")
#define RESC(a) do { if (__any((a) < 1.f)) { if (hi == 0) al_l[r32] = (a); asm volatile("s_waitcnt lgkmcnt(0)" ::: "memory"); \
    _Pragma("unroll") for (int d = 0; d < 4; ++d) _Pragma("unroll") for (int r = 0; r < 16; ++r) o[d][r] *= al_l[crow(r, hi)]; } } while (0)
  f32x16 pA0, pA1, pB0, pB1; float mnA, mnB, alA, alB; bf16x8 pa0, pa1, pa2, pa3; const int NT = seq / KVBLK;
  constexpr int SE = 0, SO = SDEPTH - 1;
  SLOAD(SE, 0); asm volatile("s_waitcnt vmcnt(0)" ::: "memory"); SWRITE(0, SE); __syncthreads();
  qkt(pA0, pA1, K_lds, qr, r32, hi); partialSM(pA0, pA1, m_reg, mnA, alA);
  SLOAD(SO, KVBLK); if (2 < NT) SLOAD(SE, 2 * KVBLK);
  SWAIT(); SWRITE(1, SO); __syncthreads();
  for (int j = 1; j + 1 < NT; j += 2) {
    SBAR(); qkt(pB0, pB1, (bf16_t*)((char*)K_lds + SHM_K), qr, r32, hi);
    finishSM(pA0, pA1, alA, l_reg, pa0, pa1, pa2, pa3); SBAR();
    SLOAD(SO, (j + SDEPTH) * KVBLK); SBAR();
    pv_sm(o, vb0, pa0, pa1, pa2, pa3, pB0, pB1, m_reg, mnB, alB);
    __syncthreads(); SWAIT(); SWRITE(0, SE);
    RESC(alB); __syncthreads();
    SBAR(); qkt(pA0, pA1, K_lds, qr, r32, hi);
    finishSM(pB0, pB1, alB, l_reg, pa0, pa1, pa2, pa3); SBAR();
    if (j + 3 < NT) SLOAD(SE, (j + 1 + SDEPTH) * KVBLK); SBAR();
    pv_sm(o, vb0 + (int)SHM_V, pa0, pa1, pa2, pa3, pA0, pA1, m_reg, mnA, alA);
    __syncthreads(); SWAIT(); SWRITE(1, SO);
    RESC(alA); __syncthreads();
  }
  SBAR(); qkt(pB0, pB1, (bf16_t*)((char*)K_lds + SHM_K), qr, r32, hi);
  finishSM(pA0, pA1, alA, l_reg, pa0, pa1, pa2, pa3); SBAR();
  pv_sm(o, vb0, pa0, pa1, pa2, pa3, pB0, pB1, m_reg, mnB, alB);
  __syncthreads(); RESC(alB);
  finishSM(pB0, pB1, alB, l_reg, pa0, pa1, pa2, pa3); SBAR();
  pv_d0(o, vb0 + (int)SHM_V, pa0, pa1, pa2, pa3);
  if (hi == 0) li_l[r32] = l_reg; asm volatile("s_waitcnt lgkmcnt(0)" ::: "memory");
  float rli[16];
#pragma unroll
  for (int r = 0; r < 16; ++r) rli[r] = __builtin_amdgcn_rcpf(li_l[crow(r, hi)]);
  bf16_t* Ow = Ob + (long)(wid * QBLK) * LDO;
#pragma unroll
  for (int r = 0; r < 16; ++r) { int orow = crow(r, hi);
#pragma unroll
    for (int d0 = 0; d0 < 4; ++d0) Ow[(long)orow * LDO + d0 * 32 + r32] = (bf16_t)(cvtpk(o[d0][r] * rli[r], 0.f) & 0xffffu); }
  __syncthreads();
#undef SLOAD
#undef SWRITE
#undef SWAIT
}

__device__ __forceinline__ void mixa_item(const bf16_t* proj, bf16_t* PA, float* LSE, int idx, LAS char* wl, int lane, const float* gqa) {
  constexpr float C = SCALE * 1.4426950408889634f;
  const int r32 = lane & 31, hi = lane >> 5;
  const int t256 = idx & 255; int rest = idx >> 8; const int h = rest & 3; rest >>= 2; const int g = rest % 3, b = rest / 3;
  const int dsh = 2 * g, dil = 1 << dsh, L = SEQ >> dsh;
  const int r = t256 >> (8 - dsh), q0 = (t256 & ((256 >> dsh) - 1)) * 32;
  const int head = g * 4 + h;
  const float slope = exp2f(-8.f * (float)(head + 1) / 12.f);
  const float bc = slope * (float)dil / SCALE;
  const bf16_t* base = proj + (size_t)(b * SEQ + r) * DIN + head * 128;
  const size_t pst = (size_t)dil * DIN;
  LAS float* al_l = (LAS float*)(wl + 16384); LAS float* li_l = al_l + 32;
  const int vb = (int)(uintptr_t)wl + v_rd_base(lane);
  bf16x8 qr[8];
  { const bf16_t* qp = base + (size_t)(q0 + r32) * pst + OFF_QA + hi * 8;
#pragma unroll
    for (int d0 = 0; d0 < 8; ++d0) qr[d0] = ld8(qp + d0 * 16); }
  { float ss = 0.f;
#pragma unroll
    for (int d0 = 0; d0 < 8; ++d0) { const u32x4 w = *reinterpret_cast<const u32x4*>(&qr[d0]);
      ss += (bflo(w.x) * bflo(w.x) + bfhi(w.x) * bfhi(w.x)) + (bflo(w.y) * bflo(w.y) + bfhi(w.y) * bfhi(w.y)) + (bflo(w.z) * bflo(w.z) + bfhi(w.z) * bfhi(w.z)) + (bflo(w.w) * bflo(w.w) + bfhi(w.w) * bfhi(w.w)); }
    { auto rr = __builtin_amdgcn_permlane32_swap(__float_as_uint(ss), __float_as_uint(ss), false, false); ss = __uint_as_float(rr[0]) + __uint_as_float(rr[1]); }
    const float rs = 1.0f / sqrtf(ss * (1.f / 128.f) + EPS);
#pragma unroll
    for (int d0 = 0; d0 < 8; ++d0) { const u32x4 w = *reinterpret_cast<const u32x4*>(&qr[d0]);
      const f32x4 g0 = *(const f32x4*)(gqa + d0 * 16 + hi * 8), g1 = *(const f32x4*)(gqa + d0 * 16 + hi * 8 + 4);
      u32x4 y; y.x = cvtpk(bflo(w.x) * rs * g0[0], bfhi(w.x) * rs * g0[1]); y.y = cvtpk(bflo(w.y) * rs * g0[2], bfhi(w.y) * rs * g0[3]);
      y.z = cvtpk(bflo(w.z) * rs * g1[0], bfhi(w.z) * rs * g1[1]); y.w = cvtpk(bflo(w.w) * rs * g1[2], bfhi(w.w) * rs * g1[3]);
      qr[d0] = *reinterpret_cast<const bf16x8*>(&y); } }
  float m_reg = -1e30f, l_reg = 0.f; f32x16 o[4] = {};
  const int qpos = q0 + r32;
#pragma unroll
  for (int ti = 0; ti < 3; ++ti) {
    const int T = (ti == 0) ? 1 : (ti == 1 ? 0 : 2);
    const int k0 = q0 - 64 + 64 * T;
    f32x16 p0 = {}, p1 = {};
    { const int ka = min(max(k0 + r32, 0), L - 1), kb = min(max(k0 + 32 + r32, 0), L - 1);
      const bf16_t* kpa = base + (size_t)ka * pst + OFF_KA + hi * 8; const bf16_t* kpb = base + (size_t)kb * pst + OFF_KA + hi * 8;
#pragma unroll
      for (int d0 = 0; d0 < 8; ++d0) { const bf16x8 b0 = ld8(kpa + d0 * 16), b1 = ld8(kpb + d0 * 16);
        p0 = __builtin_amdgcn_mfma_f32_32x32x16_bf16(b0, qr[d0], p0, 0, 0, 0);
        p1 = __builtin_amdgcn_mfma_f32_32x32x16_bf16(b1, qr[d0], p1, 0, 0, 0); } }
#pragma unroll
    for (int half = 0; half < 2; ++half) {
      bf16x8 vv[8];
#pragma unroll
      for (int i = 0; i < 8; ++i) { const int key = (half * 8 + i) * 4 + (lane >> 4); const int kp = min(max(k0 + key, 0), L - 1);
        vv[i] = ld8(base + (size_t)kp * pst + OFF_VA + (lane & 15) * 8); }
#pragma unroll
      for (int i = 0; i < 8; ++i) { const int key = (half * 8 + i) * 4 + (lane >> 4); *(LAS bf16x8*)(wl + v_st(key, (lane & 15) * 8)) = vv[i]; }
    }
#pragma unroll
    for (int rr = 0; rr < 16; ++rr) {
      const int j0 = crow(rr, hi), kp0 = k0 + j0, kp1 = kp0 + 32;
      const int d0_ = kp0 - qpos, d1_ = kp1 - qpos; const int a0 = d0_ < 0 ? -d0_ : d0_, a1 = d1_ < 0 ? -d1_ : d1_;
      const bool ok0 = (a0 <= 64) && (kp0 >= 0) && (kp0 < L), ok1 = (a1 <= 64) && (kp1 >= 0) && (kp1 < L);
      p0[rr] = ok0 ? p0[rr] - bc * (float)a0 : -1e30f;
      p1[rr] = ok1 ? p1[rr] - bc * (float)a1 : -1e30f;
    }
    float mn, alpha; bf16x8 pa0, pa1, pa2, pa3;
    partialSM(p0, p1, m_reg, mn, alpha);
    RESC(alpha);
    finishSM(p0, p1, alpha, l_reg, pa0, pa1, pa2, pa3);
    asm volatile("s_waitcnt lgkmcnt(0)" ::: "memory"); SBAR();
    pv_d0(o, vb, pa0, pa1, pa2, pa3);
  }
  if (hi == 0) li_l[r32] = l_reg; asm volatile("s_waitcnt lgkmcnt(0)" ::: "memory");
  float rli[16];
#pragma unroll
  for (int rr = 0; rr < 16; ++rr) rli[rr] = __builtin_amdgcn_rcpf(li_l[crow(rr, hi)]);
  bf16_t* Ow = PA + ((size_t)g * MTOK + (size_t)b * SEQ + r) * 512 + h * 128;
#pragma unroll
  for (int rr = 0; rr < 16; ++rr) { const int orow = crow(rr, hi); bf16_t* op = Ow + (size_t)(q0 + orow) * dil * 512;
#pragma unroll
    for (int d0 = 0; d0 < 4; ++d0) op[d0 * 32 + r32] = (bf16_t)(cvtpk(o[d0][rr] * rli[rr], 0.f) & 0xffffu); }
  if (hi == 0) LSE[((size_t)g * MTOK + (size_t)b * SEQ + (size_t)(q0 + r32) * dil + r) * 4 + h] = m_reg * C + __builtin_amdgcn_logf(l_reg);
  asm volatile("s_waitcnt lgkmcnt(0)" ::: "memory");
}
#undef RESC

__device__ __forceinline__ void sincos_f(float a, float& c, float& s) {
  const float kf = __builtin_rintf(a * 0.636619772367581343f);
  const int k = (int)kf;
  float r = __builtin_fmaf(-kf, 1.5707963705062866f, a);
  r = __builtin_fmaf(kf, 4.371139000186241e-8f, r);
  const float r2 = r * r;
  const float sp = r + r * r2 * (-1.6666667163e-1f + r2 * (8.3333337680e-3f + r2 * (-1.9841270114e-4f + r2 * 2.7557314297e-6f)));
  const float cp = 1.0f + r2 * (-0.5f + r2 * (4.1666667908e-2f + r2 * (-1.3888889225e-3f + r2 * (2.4801587642e-5f + r2 * -2.7557314297e-7f))));
  const int q = k & 3;
  s = (q == 0) ? sp : (q == 1) ? cp : (q == 2) ? -sp : -cp;
  c = (q == 0) ? cp : (q == 1) ? -sp : (q == 2) ? -cp : sp;
}

__device__ __forceinline__ void transpose_item(const float* W, int K, int N, bf16_t* WT, int k0, int n0, int drow0, LAS float* scr, int lane) {
  float wv[32];
#pragma unroll
  for (int i = 0; i < 32; ++i) { const int kk = 2 * i + (lane >> 5); wv[i] = W[(size_t)(k0 + kk) * N + n0 + (lane & 31)]; }
#pragma unroll
  for (int i = 0; i < 32; ++i) { const int kk = 2 * i + (lane >> 5); scr[kk * 33 + (lane & 31)] = wv[i]; }
  asm volatile("s_waitcnt lgkmcnt(0)" ::: "memory");
  const int c = lane & 7;
#pragma unroll
  for (int j = 0; j < 4; ++j) { const int n = (lane >> 3) + 8 * j; const LAS float* s = scr + (8 * c) * 33 + n;
    u32x4 o; o.x = cvtpk(s[0 * 33], s[1 * 33]); o.y = cvtpk(s[2 * 33], s[3 * 33]); o.z = cvtpk(s[4 * 33], s[5 * 33]); o.w = cvtpk(s[6 * 33], s[7 * 33]);
    *(u32x4*)(WT + (size_t)(drow0 + n) * K + k0 + 8 * c) = o; }
  asm volatile("s_waitcnt lgkmcnt(0)" ::: "memory");
}

__device__ __forceinline__ void phase_setup(const Params& p, LAS unsigned char* lds) {
  const int tid = otid(), wid = tid >> 6, lane = tid & 63;
  unsigned char* ws = p.ws;
  {
    LAS float* sl = (LAS float*)lds; LAS float* red = sl + 4096;
    const float* cin = p.in[1]; const float* wada = p.in[2]; const float* bada = p.in[3]; float* mod = (float*)(ws + WS_MOD);
    for (int j = obid(); j < 256; j += gridDim.x) {
      for (int i = tid; i < 4096; i += NTHREADS) { const float v = cin[i]; sl[i] = v / (1.f + __expf(-v)); }
      __syncthreads();
      const int cq = tid % 18, ks = tid / 18;
      f32x4 a0 = {0.f, 0.f, 0.f, 0.f}, a1 = {0.f, 0.f, 0.f, 0.f};
      if (ks < 28) {
        const float* wp = wada + (size_t)j * 72 + 4 * cq;
#pragma unroll 16
        for (int k = ks; k < 2048; k += 28) { const f32x4 w = *(const f32x4*)(wp + (size_t)k * NMOD); const float s0 = sl[k], s1 = sl[2048 + k]; a0 += w * s0; a1 += w * s1; }
        LAS float* rp = red + (ks * 18 + cq) * 8;
        rp[0] = a0[0]; rp[1] = a0[1]; rp[2] = a0[2]; rp[3] = a0[3]; rp[4] = a1[0]; rp[5] = a1[1]; rp[6] = a1[2]; rp[7] = a1[3];
      }
      __syncthreads();
      if (tid < 144) { const int b = tid / 72, cc = tid % 72, q = cc >> 2, e = cc & 3; float s = 0.f;
        for (int k = 0; k < 28; ++k) s += red[(k * 18 + q) * 8 + b * 4 + e];
        mod[(size_t)b * NMOD + j * 72 + cc] = s + bada[j * 72 + cc]; }
      __syncthreads();
    }
  }
  {
    float* cs = (float*)(ws + WS_CS);
    for (int e = obid() * NTHREADS + tid; e < 4096; e += gridDim.x * NTHREADS) {
      const int pos = e >> 5, i = e & 31;
      const float f = __builtin_amdgcn_exp2f(-0.4152410118609203f * (float)i);
      const float ang = (float)pos * f; float c, s; sincos_f(ang, c, s);
      cs[2 * e] = c; cs[2 * e + 1] = s;
    }
  }
  {
    LAS float* scr = (LAS float*)lds + wid * (64 * 33);
    const int gw = obid() * 8 + wid, GW = gridDim.x * 8;
    for (int it = gw; it < 47616; it += GW) {
      int job, li;
      if (it < 5632) { job = 0; li = it; } else if (it < 11264) { job = 1; li = it - 5632; } else if (it < 16896) { job = 2; li = it - 11264; }
      else if (it < 27136) { job = 3; li = it - 16896; } else if (it < 27648) { job = 4; li = it - 27136; } else if (it < 28672) { job = 5; li = it - 27648; }
      else if (it < 30720) { job = 6; li = it - 28672; } else if (it < 36352) { job = 7; li = it - 30720; } else if (it < 41984) { job = 8; li = it - 36352; } else { job = 9; li = it - 41984; }
      const float* W; int K, N; size_t dst; int mode = 0;
      switch (job) {
        case 0: W = p.in[5];  K = DM;  N = DFF; dst = WS_W13_1; mode = 1; break;
        case 1: W = p.in[6];  K = DM;  N = DFF; dst = WS_W13_1; mode = 2; break;
        case 2: W = p.in[7];  K = DFF; N = DM;  dst = WS_W2_1; break;
        case 3: W = p.in[9];  K = DM;  N = DIN; dst = WS_WIN; break;
        case 4: W = p.in[14]; K = 512; N = DM;  dst = WS_WBA; break;
        case 5: W = p.in[15]; K = 1024; N = DM; dst = WS_WBB; break;
        case 6: W = p.in[16]; K = DM;  N = DM;  dst = WS_WOUT; break;
        case 7: W = p.in[18]; K = DM;  N = DFF; dst = WS_W13_2; mode = 1; break;
        case 8: W = p.in[19]; K = DM;  N = DFF; dst = WS_W13_2; mode = 2; break;
        default: W = p.in[20]; K = DFF; N = DM; dst = WS_W2_2; break;
      }
      const int nblk = N / 32, kb = li / nblk, nb = li % nblk, n0 = nb * 32;
      int drow0 = n0;
      if (mode) drow0 = (n0 >> 7) * 256 + (n0 & 127) + (mode == 2 ? 128 : 0);
      transpose_item(W, K, N, (bf16_t*)(ws + dst), kb * 64, n0, drow0, scr, lane);
    }
  }
}

template <bool ADD, bool SRC16>
__device__ __forceinline__ void phase_norm(const void* src, const bf16_t* D, unsigned short* hout, const float* gain, const float* shift, const float* scale, bf16_t* dst) {
  const int tid = otid(), wid = tid >> 6, lane = tid & 63;
  const int stride = gridDim.x * 8;
  int curb = -1; f32x4 av[8], sv[8];
  for (int row = obid() * 8 + wid; row < MTOK; row += 2 * stride) {
    const int row2 = row + stride; const bool two = (row2 < MTOK) && ((row2 >> 13) == (row >> 13));
    const int b = row >> 13;
    if (b != curb) { curb = b;
      const f32x4* gp = (const f32x4*)gain + lane; const f32x4* shp = (const f32x4*)(shift + (size_t)b * NMOD) + lane; const f32x4* scp = (const f32x4*)(scale + (size_t)b * NMOD) + lane;
#pragma unroll
      for (int j = 0; j < 8; ++j) { av[j] = gp[64 * j] * (scp[64 * j] + 1.f); sv[j] = shp[64 * j]; } }
    const int rb = two ? row2 : row;
    f32x4 v0[8], v1[8]; u32x2 d0[8], d1[8], g0[8], g1[8]; float s0 = 0.f, s1 = 0.f;
    if (SRC16) { const u32x2* x0 = (const u32x2*)((const unsigned short*)src + (size_t)row * DM) + lane; const u32x2* x1 = (const u32x2*)((const unsigned short*)src + (size_t)rb * DM) + lane;
#pragma unroll
      for (int j = 0; j < 8; ++j) { g0[j] = x0[64 * j]; g1[j] = x1[64 * j]; } }
    else { const f32x4* x0 = (const f32x4*)((const float*)src + (size_t)row * DM) + lane; const f32x4* x1 = (const f32x4*)((const float*)src + (size_t)rb * DM) + lane;
#pragma unroll
      for (int j = 0; j < 8; ++j) { v0[j] = x0[64 * j]; v1[j] = x1[64 * j]; } }
    if (ADD) {
      const u32x2* e0 = (const u32x2*)(D + (size_t)row * DM) + lane; const u32x2* e1 = (const u32x2*)(D + (size_t)rb * DM) + lane;
#pragma unroll
      for (int j = 0; j < 8; ++j) { d0[j] = e0[64 * j]; d1[j] = e1[64 * j]; }
    }
    asm volatile("" ::: "memory");
    if (SRC16) {
#pragma unroll
      for (int j = 0; j < 8; ++j) { v0[j] = unpk_h4(g0[j]); v1[j] = unpk_h4(g1[j]); } }
    if (ADD) {
#pragma unroll
      for (int j = 0; j < 8; ++j) { v0[j] += unpk_b4(d0[j]); v1[j] += unpk_b4(d1[j]); }
    }
#pragma unroll
    for (int j = 0; j < 8; ++j) { s0 += (v0[j][0] * v0[j][0] + v0[j][1] * v0[j][1]) + (v0[j][2] * v0[j][2] + v0[j][3] * v0[j][3]);
                                  s1 += (v1[j][0] * v1[j][0] + v1[j][1] * v1[j][1]) + (v1[j][2] * v1[j][2] + v1[j][3] * v1[j][3]); }
#pragma unroll
    for (int o = 1; o < 64; o <<= 1) { s0 += __shfl_xor(s0, o); s1 += __shfl_xor(s1, o); }
    const float r0 = 1.0f / sqrtf(s0 * (1.f / DM) + EPS), r1 = 1.0f / sqrtf(s1 * (1.f / DM) + EPS);
    u32x2* o0 = (u32x2*)(dst + (size_t)row * DM) + lane; u32x2* o1 = (u32x2*)(dst + (size_t)row2 * DM) + lane;
    if (ADD) { u32x2* h0 = (u32x2*)(hout + (size_t)row * DM) + lane;
#pragma unroll
      for (int j = 0; j < 8; ++j) { u32x2 w; w.x = pkh(v0[j][0], v0[j][1]); w.y = pkh(v0[j][2], v0[j][3]); h0[64 * j] = w; } }
#pragma unroll
    for (int j = 0; j < 8; ++j) { const f32x4 y = v0[j] * r0 * av[j] + sv[j]; u32x2 w; w.x = cvtpk(y[0], y[1]); w.y = cvtpk(y[2], y[3]); o0[64 * j] = w; }
    if (two) {
      if (ADD) { u32x2* h1 = (u32x2*)(hout + (size_t)row2 * DM) + lane;
#pragma unroll
        for (int j = 0; j < 8; ++j) { u32x2 w; w.x = pkh(v1[j][0], v1[j][1]); w.y = pkh(v1[j][2], v1[j][3]); h1[64 * j] = w; } }
#pragma unroll
      for (int j = 0; j < 8; ++j) { const f32x4 y = v1[j] * r1 * av[j] + sv[j]; u32x2 w; w.x = cvtpk(y[0], y[1]); w.y = cvtpk(y[2], y[3]); o1[64 * j] = w; }
    } else if (row2 < MTOK) {
      row -= stride;
    }
  }
}
__device__ __forceinline__ void phase_final(const unsigned short* h, const bf16_t* D, const float* gain, float* out) {
  const int tid = otid(), wid = tid >> 6, lane = tid & 63;
  const int stride = gridDim.x * 8;
  f32x4 gv[8];
  { const f32x4* gp = (const f32x4*)gain + lane;
#pragma unroll
    for (int j = 0; j < 8; ++j) gv[j] = gp[64 * j]; }
  for (int row = obid() * 8 + wid; row < MTOK; row += 2 * stride) {
    const int row2 = row + stride; const bool two = row2 < MTOK; const int rb = two ? row2 : row;
    const u32x2* x0 = (const u32x2*)(h + (size_t)row * DM) + lane; const u32x2* x1 = (const u32x2*)(h + (size_t)rb * DM) + lane;
    const u32x2* e0 = (const u32x2*)(D + (size_t)row * DM) + lane; const u32x2* e1 = (const u32x2*)(D + (size_t)rb * DM) + lane;
    f32x4 v0[8], v1[8]; u32x2 g0[8], g1[8], d0[8], d1[8]; float s0 = 0.f, s1 = 0.f;
#pragma unroll
    for (int j = 0; j < 8; ++j) { g0[j] = x0[64 * j]; g1[j] = x1[64 * j]; d0[j] = e0[64 * j]; d1[j] = e1[64 * j]; }
    asm volatile("" ::: "memory");
#pragma unroll
    for (int j = 0; j < 8; ++j) { v0[j] = unpk_h4(g0[j]) + unpk_b4(d0[j]); v1[j] = unpk_h4(g1[j]) + unpk_b4(d1[j]); }
#pragma unroll
    for (int j = 0; j < 8; ++j) { s0 += (v0[j][0] * v0[j][0] + v0[j][1] * v0[j][1]) + (v0[j][2] * v0[j][2] + v0[j][3] * v0[j][3]);
                                  s1 += (v1[j][0] * v1[j][0] + v1[j][1] * v1[j][1]) + (v1[j][2] * v1[j][2] + v1[j][3] * v1[j][3]); }
#pragma unroll
    for (int o = 1; o < 64; o <<= 1) { s0 += __shfl_xor(s0, o); s1 += __shfl_xor(s1, o); }
    const float r0 = 1.0f / sqrtf(s0 * (1.f / DM) + EPS), r1 = 1.0f / sqrtf(s1 * (1.f / DM) + EPS);
    f32x4* y0 = (f32x4*)(out + (size_t)row * DM) + lane; f32x4* y1 = (f32x4*)(out + (size_t)row2 * DM) + lane;
#pragma unroll
    for (int j = 0; j < 8; ++j) y0[64 * j] = v0[j] * r0 * gv[j];
    if (two) {
#pragma unroll
      for (int j = 0; j < 8; ++j) y1[64 * j] = v1[j] * r1 * gv[j];
    }
  }
}
struct PrepTok { u32x4 raw[9]; u32x4 vraw; f32x4 cs[4]; };
__device__ __forceinline__ void prep_load(PrepTok& d, const bf16_t* proj, const float* cs, int row, int lane, int hq, int e0) {
  const int t = row & (SEQ - 1);
  const bf16_t* pr = proj + (size_t)row * DIN;
#pragma unroll
  for (int i = 3; i < 9; ++i) { const int head = 4 * i + hq; const int off = head * 128 + (i >= 6 ? 1536 : 0) + e0;
    d.raw[i] = (i < 8 || hq < 2) ? *(const u32x4*)(pr + off) : (u32x4){0u, 0u, 0u, 0u}; }
  d.vraw = (u32x4){0u, 0u, 0u, 0u};
  if (lane < 32) d.vraw = *(const u32x4*)(pr + OFF_VB + lane * 8);
  const int ee = e0 & 63, pos = (ee < 32) ? (t >> 6) : (t & 63);
  const f32x4* csp = (const f32x4*)(cs + 2 * (pos * 32 + (ee & 31)));
  d.cs[0] = csp[0]; d.cs[1] = csp[1]; d.cs[2] = csp[2]; d.cs[3] = csp[3];
}
__device__ __forceinline__ void phase_prep(const Params& p) {
  const int tid = otid(), wid = tid >> 6, lane = tid & 63, j16 = lane & 15, hq = lane >> 4, e0 = j16 * 8;
  bf16_t* proj = (bf16_t*)(p.ws + WS_P); const float* cs = (const float*)(p.ws + WS_CS);
  bf16_t* kbc = (bf16_t*)(p.ws + WS_KBC); bf16_t* vbc = (bf16_t*)(p.ws + WS_VBC);
  float gq_a[8], gk_a[8], gq_b[8], gk_b[8];
#pragma unroll
  for (int e = 0; e < 8; ++e) { gq_a[e] = p.in[10][e0 + e]; gk_a[e] = p.in[11][e0 + e]; gq_b[e] = p.in[12][e0 + e]; gk_b[e] = p.in[13][e0 + e]; }
  const float ssign = (j16 < 8) ? -1.f : 1.f;
  const int stride = gridDim.x * 8;
  int row = obid() * 8 + wid;
  PrepTok cur, nxt;
  if (row < MTOK) prep_load(cur, proj, cs, row, lane, hq, e0);
  for (; row < MTOK; row += stride) {
    const int rown = row + stride;
    if (rown < MTOK) prep_load(nxt, proj, cs, rown, lane, hq, e0);
    asm volatile("" ::: "memory");
    const int t = row & (SEQ - 1), bb = row >> 13;
    bf16_t* pr = proj + (size_t)row * DIN;
    const float cv[8] = {cur.cs[0][0], cur.cs[0][2], cur.cs[1][0], cur.cs[1][2], cur.cs[2][0], cur.cs[2][2], cur.cs[3][0], cur.cs[3][2]};
    const float sv[8] = {cur.cs[0][1], cur.cs[0][3], cur.cs[1][1], cur.cs[1][3], cur.cs[2][1], cur.cs[2][3], cur.cs[3][1], cur.cs[3][3]};
#pragma unroll
    for (int i = 3; i < 9; ++i) {
      const u32x4 rw = cur.raw[i];
      float x[8] = {bflo(rw.x), bfhi(rw.x), bflo(rw.y), bfhi(rw.y), bflo(rw.z), bfhi(rw.z), bflo(rw.w), bfhi(rw.w)};
      float ss = 0.f;
#pragma unroll
      for (int e = 0; e < 8; ++e) ss += x[e] * x[e];
      ss += __shfl_xor(ss, 1); ss += __shfl_xor(ss, 2); ss += __shfl_xor(ss, 4); ss += __shfl_xor(ss, 8);
      const float rs = 1.0f / sqrtf(ss * (1.f / 128.f) + EPS);
      float y[8];
#pragma unroll
      for (int e = 0; e < 8; ++e) y[e] = x[e] * rs * ((i < 3) ? gq_a[e] : (i < 6) ? gk_a[e] : (i < 8) ? gq_b[e] : gk_b[e]);
      if (i >= 6) {
#pragma unroll
        for (int e = 0; e < 8; ++e) { const float yp = __shfl_xor(y[e], 8); y[e] = y[e] * cv[e] + ssign * yp * sv[e]; }
      }
      u32x4 w; w.x = cvtpk(y[0], y[1]); w.y = cvtpk(y[2], y[3]); w.z = cvtpk(y[4], y[5]); w.w = cvtpk(y[6], y[7]);
      const int head = 4 * i + hq;
      if (i < 8) *(u32x4*)(pr + head * 128 + (i >= 6 ? 1536 : 0) + e0) = w;
      else if (hq < 2) *(u32x4*)(kbc + ((size_t)(bb * 2 + hq) * SEQ + t) * 128 + e0) = w;
    }
    if (lane < 32) *(u32x4*)(vbc + ((size_t)(bb * 2 + (lane >> 4)) * SEQ + t) * 128 + e0) = cur.vraw;
    asm volatile("" ::: "memory");
    cur = nxt;
  }
}
__device__ __forceinline__ void phase_attn_dense(const Params& p, unsigned char* shm, int vcu) {
  const bf16_t* proj = (const bf16_t*)(p.ws + WS_P);
  bf16_t* outb = (bf16_t*)(p.ws + WS_OUTB);
  const bf16_t* kbc = (const bf16_t*)(p.ws + WS_KBC); const bf16_t* vbc = (const bf16_t*)(p.ws + WS_VBC);
  for (int u = vcu; u < 512; u += gridDim.x) {
    const int x8 = u & 7, j32 = (u >> 3) & 31, b = u >> 8, kvh = x8 & 1, idx = (x8 >> 1) * 32 + j32, h = kvh * 4 + (idx & 3), qb = idx >> 2;
    const size_t r0 = (size_t)b * SEQ;
    attn_dense_body(proj + (r0 + qb * 256) * DIN + OFF_QB + h * 128, kbc + (size_t)(b * 2 + kvh) * SEQ * 128, vbc + (size_t)(b * 2 + kvh) * SEQ * 128,
                    outb + (r0 + qb * 256) * 1024 + h * 128, SEQ, (char*)shm);
  }
}
__device__ __forceinline__ void phase_attn_dil(const Params& p, unsigned char* shm) {
  const int tid = otid(), wid = tid >> 6, lane = tid & 63;
  const bf16_t* proj = (const bf16_t*)(p.ws + WS_P);
  LAS char* wl = (LAS char*)shm + wid * (16384 + 256);
  bf16_t* PA = (bf16_t*)(p.ws + WS_U); float* LSE = (float*)(p.ws + WS_LSE);
  for (int it = obid() * 8 + wid; it < 6144; it += gridDim.x * 8) mixa_item(proj, PA, LSE, it, wl, lane, p.in[10]);
}
struct CombIn { float l0, l1, l2; u32x4 a, b, c; };
__device__ __forceinline__ void comb_load(CombIn& d, const bf16_t* PA, const float* LSE, int i) {
  const int row = i >> 6, c8 = (i & 63) * 8, h = c8 >> 7;
  d.l0 = LSE[((size_t)0 * MTOK + row) * 4 + h]; d.l1 = LSE[((size_t)1 * MTOK + row) * 4 + h]; d.l2 = LSE[((size_t)2 * MTOK + row) * 4 + h];
  d.a = *(const u32x4*)(PA + ((size_t)0 * MTOK + row) * 512 + c8); d.b = *(const u32x4*)(PA + ((size_t)1 * MTOK + row) * 512 + c8); d.c = *(const u32x4*)(PA + ((size_t)2 * MTOK + row) * 512 + c8);
}
__device__ __forceinline__ void comb_store(const CombIn& d, bf16_t* outa, int i) {
  const int row = i >> 6, c8 = (i & 63) * 8;
  const float mx = fmaxf(d.l0, fmaxf(d.l1, d.l2));
  float w0 = __builtin_amdgcn_exp2f(d.l0 - mx), w1 = __builtin_amdgcn_exp2f(d.l1 - mx), w2 = __builtin_amdgcn_exp2f(d.l2 - mx);
  const float inv = 1.f / (w0 + w1 + w2); w0 *= inv; w1 *= inv; w2 *= inv;
  const u32x4 a = d.a, b = d.b, c = d.c;
  u32x4 o;
  o.x = cvtpk(w0 * bflo(a.x) + w1 * bflo(b.x) + w2 * bflo(c.x), w0 * bfhi(a.x) + w1 * bfhi(b.x) + w2 * bfhi(c.x));
  o.y = cvtpk(w0 * bflo(a.y) + w1 * bflo(b.y) + w2 * bflo(c.y), w0 * bfhi(a.y) + w1 * bfhi(b.y) + w2 * bfhi(c.y));
  o.z = cvtpk(w0 * bflo(a.z) + w1 * bflo(b.z) + w2 * bflo(c.z), w0 * bfhi(a.z) + w1 * bfhi(b.z) + w2 * bfhi(c.z));
  o.w = cvtpk(w0 * bflo(a.w) + w1 * bflo(b.w) + w2 * bflo(c.w), w0 * bfhi(a.w) + w1 * bfhi(b.w) + w2 * bfhi(c.w));
  *(u32x4*)(outa + (size_t)row * 512 + c8) = o;
}
__device__ __forceinline__ void phase_combine(const Params& p) {
  const bf16_t* PA = (const bf16_t*)(p.ws + WS_U); const float* LSE = (const float*)(p.ws + WS_LSE); bf16_t* outa = (bf16_t*)(p.ws + WS_OUTA);
  const int stride = gridDim.x * NTHREADS;
  for (int i = obid() * NTHREADS + otid(); i < MTOK * 64; i += 2 * stride) {
    const int i2 = i + stride; const bool two = i2 < MTOK * 64;
    CombIn d0, d1;
    comb_load(d0, PA, LSE, i); comb_load(d1, PA, LSE, two ? i2 : i);
    asm volatile("" ::: "memory");
    comb_store(d0, outa, i); if (two) comb_store(d1, outa, i2);
  }
}

#define XB_TMO      128
#define XB_XCNT(j)  (256  + 64 * (j))
#define XB_XSUB(j)  (1280 + 64 * (j))
#define XB_XGEN(j)  (2304 + 64 * (j))
#define XB_TOP      3328
#define XB_TOPGEN   3392
#define XCD_BAR_WORDS 3456
#define XB_SPIN_CAP (1u << 22)

__device__ __forceinline__ unsigned xb_ld(unsigned* p)              { return __hip_atomic_load(p, __ATOMIC_RELAXED, __HIP_MEMORY_SCOPE_AGENT); }
__device__ __forceinline__ unsigned xb_add(unsigned* p, unsigned v) { return __hip_atomic_fetch_add(p, v, __ATOMIC_RELAXED, __HIP_MEMORY_SCOPE_AGENT); }
__device__ __forceinline__ unsigned xb_xcc_id() { return (unsigned)__builtin_amdgcn_s_getreg((3 << 11) | 20) & 0xFu; }
#define XB_SPIN(cond, bar) do { unsigned _sp = 0; while (cond) { __builtin_amdgcn_s_sleep(1); \
    if ((++_sp & 255u) == 0u) { if (xb_ld(&(bar)[XB_TMO])) break; if (_sp > XB_SPIN_CAP) { atomicAdd(&(bar)[XB_TMO], 1u); break; } } } } while (0)

struct XcdBarrier {
    unsigned* bar; unsigned x;
    volatile LAS unsigned* st;
};

__device__ __forceinline__ XcdBarrier xcd_barrier_post(unsigned* bar, volatile LAS unsigned* st) {
    XcdBarrier b; b.bar = bar; b.x = xb_xcc_id(); b.st = st;
    if (threadIdx.x == 0) st[3] = xb_add(&bar[XB_XCNT(b.x)], 1u);
    return b;
}
__device__ __forceinline__ void xcd_barrier_complete(unsigned* bar, unsigned x, unsigned& nloc, unsigned& nx, unsigned& uniform) {
    const unsigned G = gridDim.x * gridDim.y * gridDim.z;
    unsigned sum, cnt, mine, okc, sp = 0u;
    for (;;) {
        sum = 0u; cnt = 0u; mine = 0u; okc = 0u;
#pragma unroll
        for (unsigned j = 0; j < 16; ++j) { const unsigned c = xb_ld(&bar[XB_XCNT(j)]); sum += c; cnt += (c > 0u) ? 1u : 0u; mine = (j == x) ? c : mine; okc += (c == ((j < 8u) ? (G >> 3) : 0u)) ? 1u : 0u; }
        if (sum == G) break;
        __builtin_amdgcn_s_sleep(1);
        if ((++sp & 255u) == 0u) { if (xb_ld(&bar[XB_TMO])) break; if (sp > XB_SPIN_CAP) { atomicAdd(&bar[XB_TMO], 1u); break; } }
    }
    nloc = mine > 0u ? mine : 1u; nx = cnt > 0u ? cnt : 1u; uniform = (sum == G && (G & 7u) == 0u && okc == 16u) ? 1u : 0u;
}

__device__ __forceinline__ void xcd_barrier(const XcdBarrier& b) {
    asm volatile("s_waitcnt vmcnt(0)" ::: "memory");
    __syncthreads();
    if (threadIdx.x == 0) {
        unsigned* bar = b.bar;
        __builtin_amdgcn_s_waitcnt(0);
        unsigned nloc = b.st[0], nx = b.st[1];
        if (nloc == 0u) { unsigned uni; xcd_barrier_complete(bar, b.x, nloc, nx, uni); b.st[0] = nloc; b.st[1] = nx; b.st[2] = uni; }
        const unsigned old = xb_add(&bar[XB_XSUB(b.x)], 1u);
        const unsigned gen = old / nloc;
        if (old + 1u == (gen + 1u) * nloc) {
            __builtin_amdgcn_fence(__ATOMIC_RELEASE, "agent");
            asm volatile("s_waitcnt vmcnt(0)" ::: "memory");
            const unsigned og = xb_add(&bar[XB_TOP], 1u);
            const unsigned tg = og / nx;
            if (og + 1u == (tg + 1u) * nx) xb_add(&bar[XB_TOPGEN], 1u);
            else XB_SPIN(xb_ld(&bar[XB_TOPGEN]) == tg, bar);
            __builtin_amdgcn_fence(__ATOMIC_ACQUIRE, "agent");
            asm volatile("s_waitcnt vmcnt(0)" ::: "memory");
        } else {
            XB_SPIN(xb_ld(&bar[XB_TOPGEN]) == gen, bar);
            __builtin_amdgcn_fence(__ATOMIC_ACQUIRE, "agent");
            asm volatile("s_waitcnt vmcnt(0)" ::: "memory");
        }
    }
    __syncthreads();
}


constexpr int NPH = 17;
__global__ void __launch_bounds__(NTHREADS) mega(Params p) {
  extern __shared__ __attribute__((aligned(16))) unsigned char shm[];
  LAS unsigned char* lds = (LAS unsigned char*)shm;
  cg::grid_group grid = cg::this_grid();
  unsigned char* ws = p.ws;
  float* mod = (float*)(ws + WS_MOD);
  bf16_t* U = (bf16_t*)(ws + WS_U); bf16_t* P = (bf16_t*)(ws + WS_P);
  volatile LAS unsigned* xst = (volatile LAS unsigned*)(lds + LDS_BYTES - 16);
  if (threadIdx.x == 0) { xst[0] = 0u; xst[1] = 0u; xst[2] = 0u; xst[3] = 0u; }
  __syncthreads();
  const XcdBarrier xb = xcd_barrier_post((unsigned*)(ws + WS_BAR), xst);
  for (int ph = p.ph_lo; ph < p.ph_hi; ++ph) {
    if (ph == 11) { asm volatile("s_waitcnt vmcnt(0)" ::: "memory"); __syncthreads(); }
    if (ph > p.ph_lo && ph != 8 && ph != 11) { if (p.ph_hi < 0) grid.sync(); else xcd_barrier(xb); }
    int vcu = blockIdx.x;
    if (ph >= 1 && xst[2] != 0u) vcu = (int)(xb.x + 8u * xst[3]);
    vcu = __builtin_amdgcn_readfirstlane(vcu); asm volatile("" : "+s"(vcu));
    switch (ph) {
      case 0: phase_setup(p, lds); break;
      case 1: phase_norm<false, false>(p.in[0], nullptr, nullptr, p.in[4], mod, mod + DM, U); break;
      case 4: phase_norm<true, false>(p.in[0], U, (unsigned short*)(ws + WS_H16), p.in[8], mod + 3 * DM, mod + 4 * DM, U); break;
      case 13: phase_norm<true, true>(ws + WS_H16, (const bf16_t*)(ws + WS_D2), (unsigned short*)(ws + WS_H16), p.in[17], mod + 6 * DM, mod + 7 * DM, U); break;
      case 2: case 14: {
        pg8::Gemm g; g.A = U; g.Bt = (const bf16_t*)(ws + (ph == 2 ? WS_W13_1 : WS_W13_2)); g.M = MTOK; g.N = 2 * DFF; g.K = DM;
        pg8::StaticOrder S; S.init(g.M, g.N, gridDim.x, vcu);
        pg8::EpiSwiGLU E; E.O = P; E.ldc = DFF;
        pg8::gemm_phase<pg8::EpiSwiGLU, pg8::StaticOrder, true, true>(lds, g, S, E);
      } break;
      case 3: case 12: case 15: {
        pg8::Gemm g; g.M = MTOK; g.N = DM;
        pg8::EpiDelta E;
        if (ph == 3) { g.A = P; g.Bt = (const bf16_t*)(ws + WS_W2_1); g.K = DFF; E.D = U; E.gate = mod + 2 * DM; E.coef = 0.5f; }
        else if (ph == 12) { g.A = U; g.Bt = (const bf16_t*)(ws + WS_WOUT); g.K = DM; E.D = (bf16_t*)(ws + WS_D2); E.gate = mod + 5 * DM; E.coef = 1.0f; }
        else { g.A = P; g.Bt = (const bf16_t*)(ws + WS_W2_2); g.K = DFF; E.D = U; E.gate = mod + 8 * DM; E.coef = 0.5f; }
        pg8::StaticOrder S; S.init(g.M, g.N, gridDim.x, vcu);
        pg8::gemm_phase<pg8::EpiDelta, pg8::StaticOrder, true, true>(lds, g, S, E);
      } break;
      case 5: {
        pg8::Gemm g; g.A = U; g.Bt = (const bf16_t*)(ws + WS_WIN); g.M = MTOK; g.N = DIN; g.K = DM;
        pg8::StaticOrder S; S.init(g.M, g.N, gridDim.x, vcu);
        pg8::EpiProj E; E.O = P; E.ldc = DIN;
        pg8::gemm_phase<pg8::EpiProj, pg8::StaticOrder, true, true>(lds, g, S, E);
      } break;
      case 6: phase_prep(p); break;
      case 7: phase_attn_dense(p, shm, vcu); break;
      case 8: __syncthreads(); phase_attn_dil(p, shm); break;
      case 9: phase_combine(p); break;
      case 10: {
        pg8::Gemm g; g.A = (const bf16_t*)(ws + WS_OUTA); g.Bt = (const bf16_t*)(ws + WS_WBA); g.M = MTOK; g.N = DM; g.K = 512;
        pg8::StaticOrder S; S.init(g.M, g.N, gridDim.x, vcu);
        pg8::EpiGate<false> E; E.T = U; E.G = P + OFF_GA; E.ldg = DIN;
        pg8::gemm_phase<pg8::EpiGate<false>, pg8::StaticOrder, true, true>(lds, g, S, E);
      } break;
      case 11: {
        pg8::Gemm g; g.A = (const bf16_t*)(ws + WS_OUTB); g.Bt = (const bf16_t*)(ws + WS_WBB); g.M = MTOK; g.N = DM; g.K = 1024;
        pg8::StaticOrder S; S.init(g.M, g.N, gridDim.x, vcu);
        pg8::EpiGate<true> E; E.T = U; E.G = P + OFF_GB; E.ldg = DIN;
        pg8::gemm_phase<pg8::EpiGate<true>, pg8::StaticOrder, true, true>(lds, g, S, E);
      } break;
      default: phase_final((const unsigned short*)(ws + WS_H16), U, p.in[21], p.out); break;
    }
  }
}

extern "C" void kernel_launch(void* const* d_in, const int* in_sizes, int n_in, void* d_out, int out_size, void* d_ws, size_t ws_size, hipStream_t stream) {
  static int grid = 0;
  if (grid == 0) {
    if (n_in != 22 || in_sizes[0] != MTOK * DM || out_size != MTOK * DM || ws_size < WS_END) {
      fprintf(stderr, "kernel_launch: shape/workspace mismatch: n_in %d in0 %d out %d ws %zu (need %zu)\n", n_in, n_in > 0 ? in_sizes[0] : -1, out_size, ws_size, (size_t)WS_END); grid = -1; return; }
    int dev = 0, cus = 0, per_cu = 0;
    if (hipGetDevice(&dev) != hipSuccess || hipDeviceGetAttribute(&cus, hipDeviceAttributeMultiprocessorCount, dev) != hipSuccess) { fprintf(stderr, "kernel_launch: device query failed\n"); grid = -1; return; }
    if (hipFuncSetAttribute((const void*)mega, hipFuncAttributeMaxDynamicSharedMemorySize, LDS_BYTES) != hipSuccess) { fprintf(stderr, "kernel_launch: hipFuncSetAttribute failed\n"); grid = -1; return; }
    if (hipOccupancyMaxActiveBlocksPerMultiprocessor(&per_cu, (const void*)mega, NTHREADS, LDS_BYTES) != hipSuccess || per_cu < 1) { fprintf(stderr, "kernel_launch: occupancy query gives %d\n", per_cu); per_cu = 1; (void)hipGetLastError(); }
    grid = cus * per_cu;
  }
  if (grid < 0) return;
  Params p{};
  for (int i = 0; i < 22; ++i) p.in[i] = (const float*)d_in[i];
  p.out = (float*)d_out; p.ws = (unsigned char*)d_ws;
  if (hipMemsetAsync((char*)d_ws + WS_BAR, 0, 16384, stream) != hipSuccess) { fprintf(stderr, "kernel_launch: memset failed\n"); return; }
#ifdef MK_MULTI
  for (int ph = 0; ph < NPH; ++ph) { p.ph_lo = ph; p.ph_hi = ph + 1; hipLaunchKernelGGL(mega, dim3(grid), dim3(NTHREADS), LDS_BYTES, stream, p); }
#else
  p.ph_lo = 0; p.ph_hi = NPH;
  void* args[] = {&p};
  const hipError_t e = hipLaunchCooperativeKernel((const void*)mega, dim3(grid), dim3(NTHREADS), args, LDS_BYTES, stream);
  if (e != hipSuccess) fprintf(stderr, "kernel_launch: cooperative launch failed: %s (grid %d)\n", hipGetErrorString(e), grid);
#endif
}
```

```cpp
#include <hip/hip_runtime.h>
#include <hip/hip_bf16.h>
#include <hip/hip_cooperative_groups.h>
#include <cstdio>
#include <cstdint>
namespace cg = cooperative_groups;

__device__ __forceinline__ int otid() { int t = threadIdx.x; asm volatile("" : "+v"(t)); return t; }
__device__ __forceinline__ int obid() { int b = blockIdx.x; asm volatile("" : "+s"(b)); return b; }

namespace pg8 {
#define PG8_LAS __attribute__((address_space(3)))
typedef unsigned short bf16_t;
typedef short bf16x8 __attribute__((ext_vector_type(8)));
typedef float f32x4 __attribute__((ext_vector_type(4)));
typedef unsigned u32x4 __attribute__((ext_vector_type(4)));
constexpr int BM = 256, BK = 64, HALF = 128, HTB = HALF * BK * 2  , STAGE_BYTES = 8 * HTB, NXCD = 8, WGM = 8;

__host__ __device__ __forceinline__ int lds_byte(int r, int c) { const int st = (r >> 4) * 2 + (c >> 5), rr = r & 15, cc = c & 31, ob = rr * 64 + cc * 2; return st * 1024 + (ob ^ (((ob >> 9) & 1) << 5)); }
__host__ __device__ __forceinline__ void stage_rc(int b, int& R, int& C) { const int st = b / 1024, sb = b % 1024, swz = sb ^ (((sb >> 9) & 1) << 5); R = (st >> 1) * 16 + swz / 64; C = (st & 1) * 32 + (swz % 64) / 2; }
__host__ __device__ __forceinline__ int perm32(int rho) { const int n = rho >> 4, i = rho & 15; return 8 * (i >> 2) + 4 * n + (i & 3); }

struct Unit { int pm, pn; };
struct Gemm { const bf16_t* A; const bf16_t* Bt; int M, N, K; };

struct StaticOrder {
    int nM, nN, nwg, G, c;
    __host__ __device__ void init(int M, int N, int G_, int c_) { nM = M / BM; nN = N / BM; nwg = nM * nN; G = G_; c = c_; }
    __host__ __device__ bool next(int i, Unit& u) const {
        const long L = (long)i * G + c; if (L >= nwg) return false;
        int wgid = (int)L; { const int q = nwg / NXCD, r = nwg % NXCD, xcd = wgid % NXCD, off = wgid / NXCD; wgid = (xcd < r ? xcd * (q + 1) : r * (q + 1) + (xcd - r) * q) + off; }
        const int nig = WGM * nN, gid = wgid / nig, fm = gid * WGM, gsz = (nM - fm) < WGM ? (nM - fm) : WGM;
        u.pm = fm + ((wgid % nig) % gsz); u.pn = (wgid % nig) / gsz; return true;
    }
    __device__ __forceinline__ void a_ready(const Unit&) const {}
    __device__ __forceinline__ void done(const Unit&) const {}
};

__device__ __forceinline__ unsigned cvt_pk_bf16(float lo, float hi) { unsigned r; asm volatile("v_cvt_pk_bf16_f32 %0, %1, %2" : "=v"(r) : "v"(lo), "v"(hi)); return r; }
typedef float f32x2 __attribute__((ext_vector_type(2)));
__device__ __forceinline__ float bf_lo(unsigned w) { return __uint_as_float(w << 16); }
__device__ __forceinline__ float bf_hi(unsigned w) { return __uint_as_float(w & 0xffff0000u); }
__device__ __forceinline__ float sigmoid_f(float v) { return __builtin_amdgcn_rcpf(1.f + __builtin_amdgcn_exp2f(-1.4426950408889634f * v)); }

struct EpiSwiGLU {
    static constexpr bool PERM = true, AFTER_DRAIN = false;
    bf16_t* O; int ldc;
    __device__ __forceinline__ void operator()(const f32x4 (&acc)[2][2][4][2], const Unit& u, int wr, int wc, int fr, int fq) const {
        const int row0 = u.pm * BM + wr * 64 + fr, col0 = u.pn * HALF + wc * 32 + 8 * fq;
#pragma unroll
        for (int ai = 0; ai < 2; ++ai)
#pragma unroll
            for (int m = 0; m < 4; ++m) {
                bf16_t* rowp = O + (size_t)(row0 + ai * HALF + m * 16) * ldc + col0;
                float v[8];
#pragma unroll
                for (int n = 0; n < 2; ++n)
#pragma unroll
                    for (int j = 0; j < 4; ++j) { const float g = acc[ai][0][m][n][j], up = acc[ai][1][m][n][j]; v[n * 4 + j] = g * sigmoid_f(g) * up; }
                u32x4 w; w.x = cvt_pk_bf16(v[0], v[1]); w.y = cvt_pk_bf16(v[2], v[3]); w.z = cvt_pk_bf16(v[4], v[5]); w.w = cvt_pk_bf16(v[6], v[7]);
                *(u32x4*)rowp = w;
            }
    }
};
struct EpiResid {
    static constexpr bool PERM = true, AFTER_DRAIN = false;
    const float* hin; float* hout; const float* gate; float coef;
    __device__ __forceinline__ void operator()(const f32x4 (&acc)[2][2][4][2], const Unit& u, int wr, int wc, int fr, int fq) const {
        const int row0 = u.pm * BM + wr * 64 + fr, col0 = u.pn * BM + wc * 32 + 8 * fq;
        const float* gp = gate + (size_t)((u.pm * BM) >> 13) * 18432 + col0;
        f32x4 gv[2][2];
#pragma unroll
        for (int bj = 0; bj < 2; ++bj)
#pragma unroll
            for (int n = 0; n < 2; ++n) gv[bj][n] = *(const f32x4*)(gp + bj * HALF + 4 * n) * coef;
#pragma unroll
        for (int ai = 0; ai < 2; ++ai) {
            f32x4 hv[4][2][2];
#pragma unroll
            for (int m = 0; m < 4; ++m)
#pragma unroll
                for (int bj = 0; bj < 2; ++bj)
#pragma unroll
                    for (int n = 0; n < 2; ++n) hv[m][bj][n] = *(const f32x4*)(hin + (size_t)(row0 + ai * HALF + m * 16) * 2048 + col0 + bj * HALF + 4 * n);
            asm volatile("" ::: "memory");
#pragma unroll
            for (int m = 0; m < 4; ++m)
#pragma unroll
                for (int bj = 0; bj < 2; ++bj)
#pragma unroll
                    for (int n = 0; n < 2; ++n) *(f32x4*)(hout + (size_t)(row0 + ai * HALF + m * 16) * 2048 + col0 + bj * HALF + 4 * n) = hv[m][bj][n] + gv[bj][n] * acc[ai][bj][m][n];
            asm volatile("" ::: "memory");
        }
    }
};
struct EpiDelta {
    static constexpr bool PERM = true, AFTER_DRAIN = false;
    bf16_t* D; const float* gate; float coef;
    __device__ __forceinline__ void operator()(const f32x4 (&acc)[2][2][4][2], const Unit& u, int wr, int wc, int fr, int fq) const {
        const int row0 = u.pm * BM + wr * 64 + fr, col0 = u.pn * BM + wc * 32 + 8 * fq;
        const float* gp = gate + (size_t)((u.pm * BM) >> 13) * 18432 + col0;
        f32x4 gv[2][2];
#pragma unroll
        for (int bj = 0; bj < 2; ++bj)
#pragma unroll
            for (int n = 0; n < 2; ++n) gv[bj][n] = *(const f32x4*)(gp + bj * HALF + 4 * n) * coef;
#pragma unroll
        for (int ai = 0; ai < 2; ++ai)
#pragma unroll
            for (int m = 0; m < 4; ++m) {
                bf16_t* rowp = D + (size_t)(row0 + ai * HALF + m * 16) * 2048 + col0;
#pragma unroll
                for (int bj = 0; bj < 2; ++bj) {
                    const f32x4 v0 = acc[ai][bj][m][0] * gv[bj][0], v1 = acc[ai][bj][m][1] * gv[bj][1];
                    u32x4 w; w.x = cvt_pk_bf16(v0[0], v0[1]); w.y = cvt_pk_bf16(v0[2], v0[3]); w.z = cvt_pk_bf16(v1[0], v1[1]); w.w = cvt_pk_bf16(v1[2], v1[3]);
                    *(u32x4*)(rowp + bj * HALF) = w;
                }
            }
    }
};
struct EpiProj {
    static constexpr bool PERM = true, AFTER_DRAIN = false;
    bf16_t* O; int ldc;
    __device__ __forceinline__ void operator()(const f32x4 (&acc)[2][2][4][2], const Unit& u, int wr, int wc, int fr, int fq) const {
        const int row0 = u.pm * BM + wr * 64 + fr, col0 = u.pn * BM + wc * 32 + 8 * fq;
#pragma unroll
        for (int ai = 0; ai < 2; ++ai)
#pragma unroll
            for (int m = 0; m < 4; ++m) {
                bf16_t* rowp = O + (size_t)(row0 + ai * HALF + m * 16) * ldc + col0;
#pragma unroll
                for (int bj = 0; bj < 2; ++bj) {
                    const f32x4 v0 = acc[ai][bj][m][0], v1 = acc[ai][bj][m][1];
                    u32x4 w; w.x = cvt_pk_bf16(v0[0], v0[1]); w.y = cvt_pk_bf16(v0[2], v0[3]); w.z = cvt_pk_bf16(v1[0], v1[1]); w.w = cvt_pk_bf16(v1[2], v1[3]);
                    *(u32x4*)(rowp + bj * HALF) = w;
                }
            }
    }
};
template <bool ADD> struct EpiGate {
    static constexpr bool PERM = true, AFTER_DRAIN = false;
    bf16_t* T; const bf16_t* G; int ldg;
    __device__ __forceinline__ void operator()(const f32x4 (&acc)[2][2][4][2], const Unit& u, int wr, int wc, int fr, int fq) const {
        const int row0 = u.pm * BM + wr * 64 + fr, col0 = u.pn * BM + wc * 32 + 8 * fq;
#pragma unroll
        for (int ai = 0; ai < 2; ++ai) {
            u32x4 gw[4][2], tw[4][2];
#pragma unroll
            for (int m = 0; m < 4; ++m)
#pragma unroll
                for (int bj = 0; bj < 2; ++bj) { const size_t row = (size_t)(row0 + ai * HALF + m * 16);
                    gw[m][bj] = *(const u32x4*)(G + row * ldg + col0 + bj * HALF);
                    if (ADD) tw[m][bj] = *(const u32x4*)(T + row * 2048 + col0 + bj * HALF); }
            asm volatile("" ::: "memory");
#pragma unroll
            for (int m = 0; m < 4; ++m)
#pragma unroll
                for (int bj = 0; bj < 2; ++bj) { const size_t row = (size_t)(row0 + ai * HALF + m * 16);
                    bf16_t* tp = T + row * 2048 + col0 + bj * HALF;
                    const f32x4 v0 = acc[ai][bj][m][0], v1 = acc[ai][bj][m][1]; const u32x4 g4 = gw[m][bj];
                    float r[8];
                    r[0] = sigmoid_f(bf_lo(g4.x)) * v0[0]; r[1] = sigmoid_f(bf_hi(g4.x)) * v0[1]; r[2] = sigmoid_f(bf_lo(g4.y)) * v0[2]; r[3] = sigmoid_f(bf_hi(g4.y)) * v0[3];
                    r[4] = sigmoid_f(bf_lo(g4.z)) * v1[0]; r[5] = sigmoid_f(bf_hi(g4.z)) * v1[1]; r[6] = sigmoid_f(bf_lo(g4.w)) * v1[2]; r[7] = sigmoid_f(bf_hi(g4.w)) * v1[3];
                    if (ADD) { const u32x4 t4 = tw[m][bj];
                        r[0] += bf_lo(t4.x); r[1] += bf_hi(t4.x); r[2] += bf_lo(t4.y); r[3] += bf_hi(t4.y); r[4] += bf_lo(t4.z); r[5] += bf_hi(t4.z); r[6] += bf_lo(t4.w); r[7] += bf_hi(t4.w); }
                    u32x4 w; w.x = cvt_pk_bf16(r[0], r[1]); w.y = cvt_pk_bf16(r[2], r[3]); w.z = cvt_pk_bf16(r[4], r[5]); w.w = cvt_pk_bf16(r[6], r[7]);
                    *(u32x4*)tp = w; }
            asm volatile("" ::: "memory");
        }
    }
};
template <class Epi, class Sched, bool ALIGN_EPI = false, bool SP2 = false>
__device__ __forceinline__ void gemm_phase(PG8_LAS unsigned char* lds, const Gemm g, const Sched& S, const Epi& E) {
    const int tid = otid(), wid = __builtin_amdgcn_readfirstlane(tid >> 6), lane = tid & 63, wr = wid >> 2, wc = wid & 3, fr = lane & 15, fq = lane >> 4;
    const int K = g.K, nt = K / BK;
    unsigned voffA[2], voffB[2];
#pragma unroll
    for (int i = 0; i < 2; ++i) { int R, C; stage_rc(tid * 16 + i * 8192, R, C); const int Rb = Epi::PERM ? ((R & ~31) + perm32(R & 31)) : R;
        voffA[i] = (unsigned)(R * K + C) * 2u; voffB[i] = (unsigned)(Rb * K + C) * 2u; }
    const size_t kstep = (size_t)(BK * 2);
    const size_t hstep = (size_t)HALF * K * 2;
    const size_t tstep = 2 * hstep;
    const unsigned ldsw = (unsigned)wid * 1024u;
    const int aoff = lds_byte(wr * 64 + fr, fq * 8), boff = lds_byte(wc * 32 + fr, fq * 8);
#define PG8_SA(b, h) (((b) * 2 + (h)) * HTB)
#define PG8_SB(b, h) ((4 + (b) * 2 + (h)) * HTB)
#define PG8_STAGE(bufoff, gbase, voff) do { _Pragma("unroll") for (int _i = 0; _i < 2; ++_i) \
        __builtin_amdgcn_global_load_lds((const unsigned*)((const char*)(gbase) + (voff)[_i]), (PG8_LAS unsigned*)(lds + (bufoff) + ldsw + _i * 8192), 16, 0, 0); } while (0)
#define PG8_LDA(dst, b, h) do { _Pragma("unroll") for (int m = 0; m < 4; ++m) _Pragma("unroll") for (int k = 0; k < 2; ++k) dst[m][k] = *(const PG8_LAS bf16x8*)(lds + PG8_SA(b, h) + aoff + m * 2048 + k * 1024); } while (0)
#define PG8_LDB(dst, b, h) do { _Pragma("unroll") for (int n = 0; n < 2; ++n) _Pragma("unroll") for (int k = 0; k < 2; ++k) dst[n][k] = *(const PG8_LAS bf16x8*)(lds + PG8_SB(b, h) + boff + n * 2048 + k * 1024); } while (0)
#define PG8_MMA(ai, bj, At, Bt) do { __builtin_amdgcn_s_setprio(1); _Pragma("unroll") for (int m = 0; m < 4; ++m) _Pragma("unroll") for (int n = 0; n < 2; ++n) _Pragma("unroll") for (int k = 0; k < 2; ++k) \
        acc[ai][bj][m][n] = __builtin_amdgcn_mfma_f32_16x16x32_bf16(Bt[n][k], At[m][k], acc[ai][bj][m][n], 0, 0, 0); __builtin_amdgcn_s_setprio(0); } while (0)
#define PG8_WAIT_V(n) asm volatile("s_waitcnt vmcnt(" #n ")" ::: "memory")
#define PG8_WAIT_L(n) asm volatile("s_waitcnt lgkmcnt(" #n ")" ::: "memory")
#define PG8_BAR __builtin_amdgcn_s_barrier()
#define PG8_SCHED __builtin_amdgcn_sched_barrier(0)
    Unit cur, nxt; int ui = 0;
    if (!S.next(0, cur)) return;
    f32x4 acc[2][2][4][2];
#pragma unroll
    for (int a = 0; a < 2; ++a)
#pragma unroll
        for (int b = 0; b < 2; ++b)
#pragma unroll
            for (int m = 0; m < 4; ++m)
#pragma unroll
                for (int n = 0; n < 2; ++n) acc[a][b][m][n] = (f32x4){0.f, 0.f, 0.f, 0.f};
    bf16x8 At[4][2], B0[2][2], B1[2][2];
    const char* cA = (const char*)g.A + (size_t)cur.pm * tstep; const char* cB = (const char*)g.Bt + (size_t)cur.pn * tstep;
    S.a_ready(cur);
    if constexpr (SP2) {
        PG8_STAGE(PG8_SB(0, 0), cB, voffB); PG8_STAGE(PG8_SB(0, 1), cB + hstep, voffB); PG8_STAGE(PG8_SA(0, 0), cA, voffA); PG8_STAGE(PG8_SA(0, 1), cA + hstep, voffA);
        if (wr == 1) PG8_BAR;
        PG8_WAIT_V(2); PG8_BAR;
        PG8_STAGE(PG8_SB(1, 0), cB + kstep, voffB); PG8_STAGE(PG8_SA(1, 0), cA + kstep, voffA); PG8_STAGE(PG8_SB(1, 1), cB + hstep + kstep, voffB);
        PG8_WAIT_V(6); PG8_BAR;
    } else {
        PG8_STAGE(PG8_SB(0, 0), cB, voffB); PG8_STAGE(PG8_SA(0, 0), cA, voffA); PG8_STAGE(PG8_SB(0, 1), cB + hstep, voffB); PG8_STAGE(PG8_SA(0, 1), cA + hstep, voffA);
        if (wr == 1) PG8_BAR;
        PG8_WAIT_V(4); PG8_BAR;
        PG8_STAGE(PG8_SB(1, 0), cB + kstep, voffB); PG8_STAGE(PG8_SA(1, 0), cA + kstep, voffA); PG8_STAGE(PG8_SB(1, 1), cB + hstep + kstep, voffB);
        PG8_WAIT_V(6); PG8_BAR;
    }
    for (;;) {
        const bool has_next = S.next(ui + 1, nxt);
        const char* nA = has_next ? (const char*)g.A + (size_t)nxt.pm * tstep : cA; const char* nB = has_next ? (const char*)g.Bt + (size_t)nxt.pn * tstep : cB;
        for (int t = 0; t < nt; t += 2) {
            const bool last = (t == nt - 2);
            const char* a1 = cA + (size_t)(t + 1) * kstep;
            const char* a2 = last ? nA : cA + (size_t)(t + 2) * kstep; const char* b2 = last ? nB : cB + (size_t)(t + 2) * kstep;
            const char* a3 = a2 + kstep; const char* b3 = b2 + kstep;
            if (last && has_next) S.a_ready(nxt);
            if constexpr (SP2) {
            PG8_LDB(B0, 0, 0); PG8_LDB(B1, 0, 1); PG8_SCHED; PG8_LDA(At, 0, 0); PG8_STAGE(PG8_SA(1, 1), a1 + hstep, voffA);
            PG8_WAIT_V(8); PG8_WAIT_L(0); PG8_BAR; PG8_MMA(0, 0, At, B0); PG8_MMA(0, 1, At, B1); PG8_BAR; PG8_SCHED;
            PG8_LDA(At, 0, 1); PG8_STAGE(PG8_SB(0, 0), b2, voffB); PG8_STAGE(PG8_SB(0, 1), b2 + hstep, voffB); PG8_STAGE(PG8_SA(0, 0), a2, voffA);
            PG8_WAIT_V(8); PG8_WAIT_L(0); PG8_BAR; PG8_MMA(1, 0, At, B0); PG8_MMA(1, 1, At, B1); PG8_BAR; PG8_SCHED;
            PG8_LDB(B0, 1, 0); PG8_LDB(B1, 1, 1); PG8_SCHED; PG8_LDA(At, 1, 0); PG8_STAGE(PG8_SA(0, 1), a2 + hstep, voffA);
            PG8_WAIT_V(8); PG8_WAIT_L(0); PG8_BAR; PG8_MMA(0, 0, At, B0); PG8_MMA(0, 1, At, B1); PG8_BAR; PG8_SCHED;
            PG8_LDA(At, 1, 1); PG8_STAGE(PG8_SB(1, 0), b3, voffB); PG8_STAGE(PG8_SB(1, 1), b3 + hstep, voffB); PG8_STAGE(PG8_SA(1, 0), a3, voffA);
            PG8_WAIT_V(8); PG8_WAIT_L(0); PG8_BAR; PG8_MMA(1, 0, At, B0); PG8_MMA(1, 1, At, B1); PG8_BAR; PG8_SCHED;
            } else {
            PG8_LDB(B0, 0, 0); PG8_SCHED; PG8_LDA(At, 0, 0); PG8_STAGE(PG8_SA(1, 1), a1 + hstep, voffA);
            PG8_WAIT_L(8); PG8_BAR; PG8_WAIT_L(0); PG8_MMA(0, 0, At, B0); PG8_BAR; PG8_SCHED;
            PG8_LDB(B1, 0, 1); PG8_STAGE(PG8_SB(0, 0), b2, voffB);
            PG8_BAR; PG8_WAIT_L(0); PG8_MMA(0, 1, At, B1); PG8_BAR;
            PG8_LDA(At, 0, 1); PG8_STAGE(PG8_SA(0, 0), a2, voffA);
            PG8_BAR; PG8_WAIT_L(0); PG8_MMA(1, 0, At, B0); PG8_BAR; PG8_SCHED;
            PG8_STAGE(PG8_SB(0, 1), b2 + hstep, voffB);
            PG8_WAIT_V(6); PG8_BAR; PG8_MMA(1, 1, At, B1); PG8_BAR;
            PG8_LDB(B0, 1, 0); PG8_SCHED; PG8_LDA(At, 1, 0); PG8_STAGE(PG8_SA(0, 1), a2 + hstep, voffA);
            PG8_WAIT_L(8); PG8_BAR; PG8_WAIT_L(0); PG8_MMA(0, 0, At, B0); PG8_BAR; PG8_SCHED;
            PG8_LDB(B1, 1, 1); PG8_STAGE(PG8_SB(1, 0), b3, voffB);
            PG8_BAR; PG8_WAIT_L(0); PG8_MMA(0, 1, At, B1); PG8_BAR;
            PG8_LDA(At, 1, 1); PG8_STAGE(PG8_SA(1, 0), a3, voffA);
            PG8_BAR; PG8_WAIT_L(0); PG8_MMA(1, 0, At, B0); PG8_BAR; PG8_SCHED;
            PG8_STAGE(PG8_SB(1, 1), b3 + hstep, voffB);
            PG8_WAIT_V(6); PG8_BAR; PG8_MMA(1, 1, At, B1); PG8_BAR;
            }
        }
        if constexpr (ALIGN_EPI) { if (wr == 0) PG8_BAR; }
        if constexpr (!Epi::AFTER_DRAIN) { E(acc, cur, wr, wc, fr, fq); S.done(cur); }
        if (!has_next) break;
#pragma unroll
        for (int a = 0; a < 2; ++a)
#pragma unroll
            for (int b = 0; b < 2; ++b)
#pragma unroll
                for (int m = 0; m < 4; ++m)
#pragma unroll
                    for (int n = 0; n < 2; ++n) acc[a][b][m][n] = (f32x4){0.f, 0.f, 0.f, 0.f};
        cur = nxt; cA = nA; cB = nB; ++ui;
        if constexpr (ALIGN_EPI) { if (wr == 1) PG8_BAR; }
    }
    PG8_WAIT_V(0);
    if constexpr (!ALIGN_EPI) { if (wr == 0) PG8_BAR; }
    PG8_BAR;
    if constexpr (Epi::AFTER_DRAIN) { E.fused(acc, cur, wr, wc, fr, fq, lds, wid, lane); S.done(cur); }
#undef PG8_SA
#undef PG8_SB
#undef PG8_STAGE
#undef PG8_LDA
#undef PG8_LDB
#undef PG8_MMA
#undef PG8_WAIT_V
#undef PG8_WAIT_L
#undef PG8_BAR
#undef PG8_SCHED
}
}

#define LAS __attribute__((address_space(3)))
typedef unsigned short bf16_t;
using bf16x8 = __attribute__((ext_vector_type(8))) short;
using s16x4  = __attribute__((ext_vector_type(4))) short;
using f32x16 = __attribute__((ext_vector_type(16))) float;
using f32x4  = __attribute__((ext_vector_type(4))) float;
using u32x4  = __attribute__((ext_vector_type(4))) unsigned;
using u32x2  = __attribute__((ext_vector_type(2))) unsigned;

constexpr int DM = 2048, SEQ = 8192, NBATCH = 2, MTOK = 16384, DFF = 5632, DIN = 10240, NMOD = 18432;
constexpr int OFF_QA = 0, OFF_KA = 1536, OFF_VA = 3072, OFF_QB = 4608, OFF_KB = 5632, OFF_VB = 5888, OFF_GA = 6144, OFF_GB = 8192;
constexpr float EPS = 1e-6f;
constexpr int NTHREADS = 512, LDS_BYTES = 136 * 1024;
constexpr size_t SZ_W13 = (size_t)2 * DFF * DM * 2, SZ_W2 = (size_t)DM * DFF * 2, SZ_WIN = (size_t)DIN * DM * 2, SZ_WBA = (size_t)DM * 512 * 2, SZ_WBB = (size_t)DM * 1024 * 2, SZ_WOUT = (size_t)DM * DM * 2;
constexpr size_t WS_W13_1 = 0, WS_W2_1 = WS_W13_1 + SZ_W13, WS_WIN = WS_W2_1 + SZ_W2, WS_WBA = WS_WIN + SZ_WIN, WS_WBB = WS_WBA + SZ_WBA, WS_WOUT = WS_WBB + SZ_WBB,
                 WS_W13_2 = WS_WOUT + SZ_WOUT, WS_W2_2 = WS_W13_2 + SZ_W13, WS_MOD = WS_W2_2 + SZ_W2, WS_CS = WS_MOD + (size_t)NBATCH * NMOD * 4, WS_LSE = WS_CS + 128 * 32 * 8,
                 WS_H16 = WS_LSE + (size_t)3 * MTOK * 4 * 4, WS_U = WS_H16 + (size_t)MTOK * DM * 2, WS_P = WS_U + (size_t)MTOK * DM * 2, WS_BAR = WS_P + (size_t)MTOK * DIN * 2, WS_END = WS_BAR + 16384;
constexpr size_t WS_OUTA = WS_W13_1, WS_OUTB = WS_OUTA + (size_t)MTOK * 512 * 2;
constexpr size_t WS_KBC = WS_OUTB + (size_t)MTOK * 1024 * 2, WS_VBC = WS_KBC + (size_t)MTOK * 256 * 2;
static_assert(WS_VBC + (size_t)MTOK * 256 * 2 <= WS_WIN, "overlay");
constexpr size_t WS_D2 = WS_W13_1;
static_assert(WS_D2 + (size_t)MTOK * DM * 2 <= WS_WIN, "overlay");

struct Params { const float* in[22]; float* out; unsigned char* ws; int ph_lo, ph_hi; };

__device__ __forceinline__ unsigned cvtpk(float lo, float hi) { unsigned r; asm volatile("v_cvt_pk_bf16_f32 %0, %1, %2" : "=v"(r) : "v"(lo), "v"(hi)); return r; }
__device__ __forceinline__ float bflo(unsigned w) { return __uint_as_float(w << 16); }
__device__ __forceinline__ float bfhi(unsigned w) { return __uint_as_float(w & 0xffff0000u); }
typedef _Float16 h16x2 __attribute__((ext_vector_type(2)));
__device__ __forceinline__ unsigned pkh(float a, float b) { h16x2 v = {(_Float16)a, (_Float16)b}; return __builtin_bit_cast(unsigned, v); }
__device__ __forceinline__ float h2f(unsigned h) { const float m = __uint_as_float((h & 0x7fffu) << 13) * 0x1p112f; return __uint_as_float(__float_as_uint(m) | ((h & 0x8000u) << 16)); }
__device__ __forceinline__ f32x4 unpk_h4(u32x2 w) { return (f32x4){h2f(w.x & 0xffffu), h2f(w.x >> 16), h2f(w.y & 0xffffu), h2f(w.y >> 16)}; }
__device__ __forceinline__ f32x4 unpk_b4(u32x2 w) { return (f32x4){bflo(w.x), bfhi(w.x), bflo(w.y), bfhi(w.y)}; }
__device__ __forceinline__ float wave_sum(float v) {
#pragma unroll
    for (int o = 1; o < 64; o <<= 1) v += __shfl_xor(v, o);
    return v;
}

constexpr int D = 128, NW = 8, QBLK = 32, KVBLK = 64;
constexpr float SCALE = 0.088388347648318440f;
constexpr float THR = 8.f;
constexpr int LDQ = DIN, LDK = 128, LDO = 1024;
constexpr size_t SHM_V = KVBLK * D * 2, SHM_K = KVBLK * D * 2, SHM_ATTN = 2 * SHM_V + 2 * SHM_K + NW * 64 * 4;
#define KSWZ(row, colB) ((row) * 256 + ((colB) ^ (((row) & 7) << 4)))
#define SBAR() __builtin_amdgcn_sched_barrier(0)
__device__ __forceinline__ int crow(int r, int hi) { return (r & 3) + 8 * (r >> 2) + 4 * hi; }

__device__ __forceinline__ void partialSM(f32x16& p0, f32x16& p1, float& m_reg, float& mn, float& alpha) {
  constexpr float C = SCALE * 1.4426950408889634f;
  float pmax = p0[0];
#pragma unroll
  for (int r = 1; r < 16; ++r) pmax = fmaxf(pmax, p0[r]);
#pragma unroll
  for (int r = 0; r < 16; ++r) pmax = fmaxf(pmax, p1[r]);
  { auto rr = __builtin_amdgcn_permlane32_swap(__float_as_uint(pmax), __float_as_uint(pmax), false, false);
    pmax = fmaxf(__uint_as_float(rr[0]), __uint_as_float(rr[1])); }
  if (__builtin_expect(__all(pmax - m_reg <= THR / SCALE), 1)) { mn = m_reg; alpha = 1.f; }
  else { mn = fmaxf(m_reg, pmax); alpha = __builtin_amdgcn_exp2f((m_reg - mn) * C); m_reg = mn; }
  float mnC = -mn * C;
#pragma unroll
  for (int r = 0; r < 16; ++r) p0[r] = fmaf(p0[r], C, mnC);
#pragma unroll
  for (int r = 0; r < 16; ++r) p1[r] = fmaf(p1[r], C, mnC);
#pragma unroll
  for (int r = 0; r < 16; ++r) p0[r] = __builtin_amdgcn_exp2f(p0[r]);
}
__device__ __forceinline__ void finishSM(f32x16& p0, f32x16& p1, float alpha, float& l_reg, bf16x8& pa0, bf16x8& pa1, bf16x8& pa2, bf16x8& pa3) {
#pragma unroll
  for (int r = 0; r < 16; ++r) p1[r] = __builtin_amdgcn_exp2f(p1[r]);
  float ps = 0;
#pragma unroll
  for (int r = 0; r < 16; ++r) ps += p0[r];
#pragma unroll
  for (int r = 0; r < 16; ++r) ps += p1[r];
  { auto rr = __builtin_amdgcn_permlane32_swap(__float_as_uint(ps), __float_as_uint(ps), false, false);
    ps = __uint_as_float(rr[0]) + __uint_as_float(rr[1]); }
  l_reg = l_reg * alpha + ps;
#define PK4(P, BASE, OUT) do { unsigned a0 = cvtpk(P[BASE + 0], P[BASE + 1]), a1 = cvtpk(P[BASE + 2], P[BASE + 3]);   \
    unsigned b0 = cvtpk(P[BASE + 4], P[BASE + 5]), b1 = cvtpk(P[BASE + 6], P[BASE + 7]);                              \
    auto r0 = __builtin_amdgcn_permlane32_swap(a0, b0, false, false); auto r1 = __builtin_amdgcn_permlane32_swap(a1, b1, false, false); \
    u32x4 w = {r0[0], r1[0], r0[1], r1[1]}; OUT = *reinterpret_cast<bf16x8*>(&w); } while (0)
  PK4(p0, 0, pa0); PK4(p0, 8, pa1); PK4(p1, 0, pa2); PK4(p1, 8, pa3);
#undef PK4
}
__device__ __forceinline__ void qkt(f32x16& p0, f32x16& p1, const bf16_t* Ks, const bf16x8* qr, int r32, int hi) {
  p0 = f32x16{}; p1 = f32x16{};
#pragma unroll
  for (int d0 = 0; d0 < 8; ++d0) { int cb = (d0 * 16 + hi * 8) * 2;
    bf16x8 b0 = *reinterpret_cast<const bf16x8*>((const char*)Ks + KSWZ(r32, cb));
    bf16x8 b1 = *reinterpret_cast<const bf16x8*>((const char*)Ks + KSWZ(32 + r32, cb));
    p0 = __builtin_amdgcn_mfma_f32_32x32x16_bf16(b0, qr[d0], p0, 0, 0, 0);
    p1 = __builtin_amdgcn_mfma_f32_32x32x16_bf16(b1, qr[d0], p1, 0, 0, 0); }
}
__device__ __forceinline__ int v_st(int k, int c) { const int kk = (k & ~0xC) | ((k & 4) << 1) | ((k & 8) >> 1); return ((kk >> 3) * 4 + (c >> 5)) * 512 + ((kk & 7) * 32 + (c & 31)) * 2; }
__device__ __forceinline__ int v_rd_base(int lane) { return ((lane & 3) << 3) | (((lane >> 2) & 3) << 6) | (((lane >> 4) & 1) << 5) | (((lane >> 5) & 1) << 8); }
constexpr int v_rd_off(int d0, int ks, int half) { return d0 * 512 + ks * 4096 + half * 2048; }
template <int OFF> __device__ __forceinline__ s16x4 tr_read(int vb) {
  s16x4 r; asm volatile("ds_read_b64_tr_b16 %0, %1 offset:%2" : "=&v"(r) : "v"(vb), "i"(OFF) : "memory"); return r;
}
template <int D0> __device__ __forceinline__ void pv_one(f32x16& od, int vb, bf16x8 pa0, bf16x8 pa1, bf16x8 pa2, bf16x8 pa3) {
  const s16x4 l0 = tr_read<v_rd_off(D0, 0, 0)>(vb), h0 = tr_read<v_rd_off(D0, 0, 1)>(vb), l1 = tr_read<v_rd_off(D0, 1, 0)>(vb), h1 = tr_read<v_rd_off(D0, 1, 1)>(vb);
  const s16x4 l2 = tr_read<v_rd_off(D0, 2, 0)>(vb), h2 = tr_read<v_rd_off(D0, 2, 1)>(vb), l3 = tr_read<v_rd_off(D0, 3, 0)>(vb), h3 = tr_read<v_rd_off(D0, 3, 1)>(vb);
  asm volatile("s_waitcnt lgkmcnt(0)" ::: "memory"); SBAR();
#define PK(L, H) (bf16x8){L[0], L[1], L[2], L[3], H[0], H[1], H[2], H[3]}
  od = __builtin_amdgcn_mfma_f32_32x32x16_bf16(pa0, PK(l0, h0), od, 0, 0, 0);
  od = __builtin_amdgcn_mfma_f32_32x32x16_bf16(pa1, PK(l1, h1), od, 0, 0, 0);
  od = __builtin_amdgcn_mfma_f32_32x32x16_bf16(pa2, PK(l2, h2), od, 0, 0, 0);
  od = __builtin_amdgcn_mfma_f32_32x32x16_bf16(pa3, PK(l3, h3), od, 0, 0, 0);
#undef PK
}
__device__ __forceinline__ void pv_d0(f32x16* o, int vb, bf16x8 pa0, bf16x8 pa1, bf16x8 pa2, bf16x8 pa3) {
  pv_one<0>(o[0], vb, pa0, pa1, pa2, pa3); pv_one<1>(o[1], vb, pa0, pa1, pa2, pa3); pv_one<2>(o[2], vb, pa0, pa1, pa2, pa3); pv_one<3>(o[3], vb, pa0, pa1, pa2, pa3);
}
#define PINF(x) asm volatile("" : "+v"(x))
#define PIN16(P) do { _Pragma("unroll") for (int r_ = 0; r_ < 16; ++r_) { float t_ = P[r_]; PINF(t_); P[r_] = t_; } } while (0)
__device__ __forceinline__ void pv_sm(f32x16* o, int vb, bf16x8 pa0, bf16x8 pa1, bf16x8 pa2, bf16x8 pa3, f32x16& p0, f32x16& p1, float& m_reg, float& mn, float& alpha) {
  constexpr float C = SCALE * 1.4426950408889634f;
  pv_one<0>(o[0], vb, pa0, pa1, pa2, pa3);
  float pmax = p0[0];
#pragma unroll
  for (int r = 1; r < 16; ++r) pmax = fmaxf(pmax, p0[r]);
  PINF(pmax);
  pv_one<1>(o[1], vb, pa0, pa1, pa2, pa3);
#pragma unroll
  for (int r = 0; r < 16; ++r) pmax = fmaxf(pmax, p1[r]);
  { auto rr = __builtin_amdgcn_permlane32_swap(__float_as_uint(pmax), __float_as_uint(pmax), false, false);
    pmax = fmaxf(__uint_as_float(rr[0]), __uint_as_float(rr[1])); }
  const bool keep = __all(pmax - m_reg <= THR / SCALE);
  const float mnew = fmaxf(m_reg, pmax);
  const float a2 = __builtin_amdgcn_exp2f((m_reg - mnew) * C);
  mn = keep ? m_reg : mnew; alpha = keep ? 1.f : a2; m_reg = mn;
  float mnC = -mn * C;
  PINF(mnC); PINF(alpha);
  pv_one<2>(o[2], vb, pa0, pa1, pa2, pa3);
#pragma unroll
  for (int r = 0; r < 16; ++r) p0[r] = fmaf(p0[r], C, mnC);
#pragma unroll
  for (int r = 0; r < 16; ++r) p1[r] = fmaf(p1[r], C, mnC);
  PIN16(p0); PIN16(p1);
  pv_one<3>(o[3], vb, pa0, pa1, pa2, pa3);
#pragma unroll
  for (int r = 0; r < 16; ++r) p0[r] = __builtin_amdgcn_exp2f(p0[r]);
  PIN16(p0);
  SBAR();
}
__device__ __forceinline__ bf16x8 ld8(const bf16_t* p) { return *reinterpret_cast<const bf16x8*>(p); }

__device__ __forceinline__ void attn_dense_body(const bf16_t* Qb, const bf16_t* Kh, const bf16_t* Vh, bf16_t* Ob, int seq, char* lds, const float* gq, const float* cs, int t0) {
  constexpr int SDEPTH = 2;
  const int tid = otid(), wid = tid >> 6, lane = tid & 63, r32 = lane & 31, hi = lane >> 5;
  bf16_t* V_lds = (bf16_t*)lds; bf16_t* K_lds = (bf16_t*)(lds + 2 * SHM_V);
  float* ws = (float*)(lds + 2 * SHM_V + 2 * SHM_K) + wid * 64; float* li_l = ws; float* al_l = ws + 32;
  float m_reg = -1e30f, l_reg = 0; f32x16 o[4] = {}; bf16x8 qr[8];
  const bf16_t* Qw = Qb + (long)(wid * QBLK + r32) * LDQ + hi * 8;
#pragma unroll
  for (int d0 = 0; d0 < 8; ++d0) qr[d0] = ld8(Qw + d0 * 16);
  { float xv[8][8]; float ss = 0.f;
#pragma unroll
    for (int d0 = 0; d0 < 8; ++d0) { const u32x4 w = *reinterpret_cast<const u32x4*>(&qr[d0]);
      xv[d0][0] = bflo(w.x); xv[d0][1] = bfhi(w.x); xv[d0][2] = bflo(w.y); xv[d0][3] = bfhi(w.y); xv[d0][4] = bflo(w.z); xv[d0][5] = bfhi(w.z); xv[d0][6] = bflo(w.w); xv[d0][7] = bfhi(w.w);
#pragma unroll
      for (int e = 0; e < 8; ++e) ss += xv[d0][e] * xv[d0][e]; }
    { auto rr = __builtin_amdgcn_permlane32_swap(__float_as_uint(ss), __float_as_uint(ss), false, false); ss = __uint_as_float(rr[0]) + __uint_as_float(rr[1]); }
    const float rs = 1.0f / sqrtf(ss * (1.f / 128.f) + EPS);
#pragma unroll
    for (int d0 = 0; d0 < 8; ++d0) { const f32x4 g0 = *(const f32x4*)(gq + d0 * 16 + hi * 8), g1 = *(const f32x4*)(gq + d0 * 16 + hi * 8 + 4);
#pragma unroll
      for (int e = 0; e < 4; ++e) { xv[d0][e] = xv[d0][e] * rs * g0[e]; xv[d0][4 + e] = xv[d0][4 + e] * rs * g1[e]; } }
    const int tq = t0 + wid * QBLK + r32;
#pragma unroll
    for (int d0 = 0; d0 < 4; ++d0) { const int pos = (d0 < 2) ? (tq >> 6) : (tq & 63);
      const f32x4* cp = (const f32x4*)(cs + 2 * (pos * 32 + (d0 & 1) * 16 + hi * 8));
      const f32x4 c0 = cp[0], c1 = cp[1], c2 = cp[2], c3 = cp[3];
      const float cv[8] = {c0[0], c0[2], c1[0], c1[2], c2[0], c2[2], c3[0], c3[2]}, sv[8] = {c0[1], c0[3], c1[1], c1[3], c2[1], c2[3], c3[1], c3[3]};
#pragma unroll
      for (int e = 0; e < 8; ++e) { const float x1 = xv[d0][e], x2 = xv[d0 + 4][e]; xv[d0][e] = x1 * cv[e] - x2 * sv[e]; xv[d0 + 4][e] = x1 * sv[e] + x2 * cv[e]; } }
#pragma unroll
    for (int d0 = 0; d0 < 8; ++d0) { u32x4 y; y.x = cvtpk(xv[d0][0], xv[d0][1]); y.y = cvtpk(xv[d0][2], xv[d0][3]); y.z = cvtpk(xv[d0][4], xv[d0][5]); y.w = cvtpk(xv[d0][6], xv[d0][7]);
      qr[d0] = *reinterpret_cast<const bf16x8*>(&y); } }
  const int sr = tid >> 4, sc = (tid & 15) * 8, vst0 = v_st(sr, sc), vst1 = v_st(32 + sr, sc);
  const int vb0 = (int)(uintptr_t)V_lds + v_rd_base(lane);
  struct { bf16x8 vs0, vs1, ks0, ks1; } sr_[SDEPTH];
#define SLOAD(i, k0) do { sr_[i].vs0 = ld8(&Vh[(long)((k0) + sr) * LDK + sc]); sr_[i].vs1 = ld8(&Vh[(long)((k0) + 32 + sr) * LDK + sc]); \
    sr_[i].ks0 = ld8(&Kh[(long)((k0) + sr) * LDK + sc]); sr_[i].ks1 = ld8(&Kh[(long)((k0) + 32 + sr) * LDK + sc]); } while (0)
#define SWRITE(b, i) do { *(bf16x8*)((char*)V_lds + (b) * SHM_V + vst0) = sr_[i].vs0;          \
    *(bf16x8*)((char*)V_lds + (b) * SHM_V + vst1) = sr_[i].vs1; int kc = sc * 2;               \
    *(bf16x8*)((char*)K_lds + (b) * SHM_K + KSWZ(sr, kc)) = sr_[i].ks0;                       \
    *(bf16x8*)((char*)K_lds + (b) * SHM_K + KSWZ(32 + sr, kc)) = sr_[i].ks1; } while (0)
#define SWAIT() asm volatile("s_waitcnt vmcnt(4)" ::: "memory")
#define RESC(a) do { if (__any((a) < 1.f)) { if (hi == 0) al_l[r32] = (a); asm volatile("s_waitcnt lgkmcnt(0)" ::: "memory"); \
    _Pragma("unroll") for (int d = 0; d < 4; ++d) _Pragma("unroll") for (int r = 0; r < 16; ++r) o[d][r] *= al_l[crow(r, hi)]; } } while (0)
  f32x16 pA0, pA1, pB0, pB1; float mnA, mnB, alA, alB; bf16x8 pa0, pa1, pa2, pa3; const int NT = seq / KVBLK;
  constexpr int SE = 0, SO = SDEPTH - 1;
  SLOAD(SE, 0); asm volatile("s_waitcnt vmcnt(0)" ::: "memory"); SWRITE(0, SE); __syncthreads();
  qkt(pA0, pA1, K_lds, qr, r32, hi); partialSM(pA0, pA1, m_reg, mnA, alA);
  SLOAD(SO, KVBLK); if (2 < NT) SLOAD(SE, 2 * KVBLK);
  SWAIT(); SWRITE(1, SO); __syncthreads();
  for (int j = 1; j + 1 < NT; j += 2) {
    SBAR(); qkt(pB0, pB1, (bf16_t*)((char*)K_lds + SHM_K), qr, r32, hi);
    finishSM(pA0, pA1, alA, l_reg, pa0, pa1, pa2, pa3); SBAR();
    SLOAD(SO, (j + SDEPTH) * KVBLK); SBAR();
    pv_sm(o, vb0, pa0, pa1, pa2, pa3, pB0, pB1, m_reg, mnB, alB);
    __syncthreads(); SWAIT(); SWRITE(0, SE);
    RESC(alB); __syncthreads();
    SBAR(); qkt(pA0, pA1, K_lds, qr, r32, hi);
    finishSM(pB0, pB1, alB, l_reg, pa0, pa1, pa2, pa3); SBAR();
    if (j + 3 < NT) SLOAD(SE, (j + 1 + SDEPTH) * KVBLK); SBAR();
    pv_sm(o, vb0 + (int)SHM_V, pa0, pa1, pa2, pa3, pA0, pA1, m_reg, mnA, alA);
    __syncthreads(); SWAIT(); SWRITE(1, SO);
    RESC(alA); __syncthreads();
  }
  SBAR(); qkt(pB0, pB1, (bf16_t*)((char*)K_lds + SHM_K), qr, r32, hi);
  finishSM(pA0, pA1, alA, l_reg, pa0, pa1, pa2, pa3); SBAR();
  pv_sm(o, vb0, pa0, pa1, pa2, pa3, pB0, pB1, m_reg, mnB, alB);
  __syncthreads(); RESC(alB);
  finishSM(pB0, pB1, alB, l_reg, pa0, pa1, pa2, pa3); SBAR();
  pv_d0(o, vb0 + (int)SHM_V, pa0, pa1, pa2, pa3);
  if (hi == 0) li_l[r32] = l_reg; asm volatile("s_waitcnt lgkmcnt(0)" ::: "memory");
  float rli[16];
#pragma unroll
  for (int r = 0; r < 16; ++r) rli[r] = __builtin_amdgcn_rcpf(li_l[crow(r, hi)]);
  bf16_t* Ow = Ob + (long)(wid * QBLK) * LDO;
#pragma unroll
  for (int r = 0; r < 16; ++r) { int orow = crow(r, hi);
#pragma unroll
    for (int d0 = 0; d0 < 4; ++d0) Ow[(long)orow * LDO + d0 * 32 + r32] = (bf16_t)(cvtpk(o[d0][r] * rli[r], 0.f) & 0xffffu); }
  __syncthreads();
#undef SLOAD
#undef SWRITE
#undef SWAIT
}

__device__ __forceinline__ void mixa_item(const bf16_t* proj, bf16_t* PA, float* LSE, int idx, LAS char* wl, int lane, const float* gqa) {
  constexpr float C = SCALE * 1.4426950408889634f;
  const int r32 = lane & 31, hi = lane >> 5;
  const int t256 = idx & 255; int rest = idx >> 8; const int h = rest & 3; rest >>= 2; const int g = rest % 3, b = rest / 3;
  const int dsh = 2 * g, dil = 1 << dsh, L = SEQ >> dsh;
  const int r = t256 >> (8 - dsh), q0 = (t256 & ((256 >> dsh) - 1)) * 32;
  const int head = g * 4 + h;
  const float slope = exp2f(-8.f * (float)(head + 1) / 12.f);
  const float bc = slope * (float)dil / SCALE;
  const bf16_t* base = proj + (size_t)(b * SEQ + r) * DIN + head * 128;
  const size_t pst = (size_t)dil * DIN;
  LAS float* al_l = (LAS float*)(wl + 16384); LAS float* li_l = al_l + 32;
  const int vb = (int)(uintptr_t)wl + v_rd_base(lane);
  bf16x8 qr[8];
  { const bf16_t* qp = base + (size_t)(q0 + r32) * pst + OFF_QA + hi * 8;
#pragma unroll
    for (int d0 = 0; d0 < 8; ++d0) qr[d0] = ld8(qp + d0 * 16); }
  { float ss = 0.f;
#pragma unroll
    for (int d0 = 0; d0 < 8; ++d0) { const u32x4 w = *reinterpret_cast<const u32x4*>(&qr[d0]);
      ss += (bflo(w.x) * bflo(w.x) + bfhi(w.x) * bfhi(w.x)) + (bflo(w.y) * bflo(w.y) + bfhi(w.y) * bfhi(w.y)) + (bflo(w.z) * bflo(w.z) + bfhi(w.z) * bfhi(w.z)) + (bflo(w.w) * bflo(w.w) + bfhi(w.w) * bfhi(w.w)); }
    { auto rr = __builtin_amdgcn_permlane32_swap(__float_as_uint(ss), __float_as_uint(ss), false, false); ss = __uint_as_float(rr[0]) + __uint_as_float(rr[1]); }
    const float rs = 1.0f / sqrtf(ss * (1.f / 128.f) + EPS);
#pragma unroll
    for (int d0 = 0; d0 < 8; ++d0) { const u32x4 w = *reinterpret_cast<const u32x4*>(&qr[d0]);
      const f32x4 g0 = *(const f32x4*)(gqa + d0 * 16 + hi * 8), g1 = *(const f32x4*)(gqa + d0 * 16 + hi * 8 + 4);
      u32x4 y; y.x = cvtpk(bflo(w.x) * rs * g0[0], bfhi(w.x) * rs * g0[1]); y.y = cvtpk(bflo(w.y) * rs * g0[2], bfhi(w.y) * rs * g0[3]);
      y.z = cvtpk(bflo(w.z) * rs * g1[0], bfhi(w.z) * rs * g1[1]); y.w = cvtpk(bflo(w.w) * rs * g1[2], bfhi(w.w) * rs * g1[3]);
      qr[d0] = *reinterpret_cast<const bf16x8*>(&y); } }
  float m_reg = -1e30f, l_reg = 0.f; f32x16 o[4] = {};
  const int qpos = q0 + r32;
#pragma unroll
  for (int ti = 0; ti < 3; ++ti) {
    const int T = (ti == 0) ? 1 : (ti == 1 ? 0 : 2);
    const int k0 = q0 - 64 + 64 * T;
    f32x16 p0 = {}, p1 = {};
    { const int ka = min(max(k0 + r32, 0), L - 1), kb = min(max(k0 + 32 + r32, 0), L - 1);
      const bf16_t* kpa = base + (size_t)ka * pst + OFF_KA + hi * 8; const bf16_t* kpb = base + (size_t)kb * pst + OFF_KA + hi * 8;
#pragma unroll
      for (int d0 = 0; d0 < 8; ++d0) { const bf16x8 b0 = ld8(kpa + d0 * 16), b1 = ld8(kpb + d0 * 16);
        p0 = __builtin_amdgcn_mfma_f32_32x32x16_bf16(b0, qr[d0], p0, 0, 0, 0);
        p1 = __builtin_amdgcn_mfma_f32_32x32x16_bf16(b1, qr[d0], p1, 0, 0, 0); } }
#pragma unroll
    for (int half = 0; half < 2; ++half) {
      bf16x8 vv[8];
#pragma unroll
      for (int i = 0; i < 8; ++i) { const int key = (half * 8 + i) * 4 + (lane >> 4); const int kp = min(max(k0 + key, 0), L - 1);
        vv[i] = ld8(base + (size_t)kp * pst + OFF_VA + (lane & 15) * 8); }
#pragma unroll
      for (int i = 0; i < 8; ++i) { const int key = (half * 8 + i) * 4 + (lane >> 4); *(LAS bf16x8*)(wl + v_st(key, (lane & 15) * 8)) = vv[i]; }
    }
#pragma unroll
    for (int rr = 0; rr < 16; ++rr) {
      const int j0 = crow(rr, hi), kp0 = k0 + j0, kp1 = kp0 + 32;
      const int d0_ = kp0 - qpos, d1_ = kp1 - qpos; const int a0 = d0_ < 0 ? -d0_ : d0_, a1 = d1_ < 0 ? -d1_ : d1_;
      const bool ok0 = (a0 <= 64) && (kp0 >= 0) && (kp0 < L), ok1 = (a1 <= 64) && (kp1 >= 0) && (kp1 < L);
      p0[rr] = ok0 ? p0[rr] - bc * (float)a0 : -1e30f;
      p1[rr] = ok1 ? p1[rr] - bc * (float)a1 : -1e30f;
    }
    float mn, alpha; bf16x8 pa0, pa1, pa2, pa3;
    partialSM(p0, p1, m_reg, mn, alpha);
    RESC(alpha);
    finishSM(p0, p1, alpha, l_reg, pa0, pa1, pa2, pa3);
    asm volatile("s_waitcnt lgkmcnt(0)" ::: "memory"); SBAR();
    pv_d0(o, vb, pa0, pa1, pa2, pa3);
  }
  if (hi == 0) li_l[r32] = l_reg; asm volatile("s_waitcnt lgkmcnt(0)" ::: "memory");
  float rli[16];
#pragma unroll
  for (int rr = 0; rr < 16; ++rr) rli[rr] = __builtin_amdgcn_rcpf(li_l[crow(rr, hi)]);
  bf16_t* Ow = PA + ((size_t)g * MTOK + (size_t)b * SEQ + r) * 512 + h * 128;
#pragma unroll
  for (int rr = 0; rr < 16; ++rr) { const int orow = crow(rr, hi); bf16_t* op = Ow + (size_t)(q0 + orow) * dil * 512;
#pragma unroll
    for (int d0 = 0; d0 < 4; ++d0) op[d0 * 32 + r32] = (bf16_t)(cvtpk(o[d0][rr] * rli[rr], 0.f) & 0xffffu); }
  if (hi == 0) LSE[((size_t)g * MTOK + (size_t)b * SEQ + (size_t)(q0 + r32) * dil + r) * 4 + h] = m_reg * C + __builtin_amdgcn_logf(l_reg);
  asm volatile("s_waitcnt lgkmcnt(0)" ::: "memory");
}
#undef RESC

__device__ __forceinline__ void sincos_f(float a, float& c, float& s) {
  const float kf = __builtin_rintf(a * 0.636619772367581343f);
  const int k = (int)kf;
  float r = __builtin_fmaf(-kf, 1.5707963705062866f, a);
  r = __builtin_fmaf(kf, 4.371139000186241e-8f, r);
  const float r2 = r * r;
  const float sp = r + r * r2 * (-1.6666667163e-1f + r2 * (8.3333337680e-3f + r2 * (-1.9841270114e-4f + r2 * 2.7557314297e-6f)));
  const float cp = 1.0f + r2 * (-0.5f + r2 * (4.1666667908e-2f + r2 * (-1.3888889225e-3f + r2 * (2.4801587642e-5f + r2 * -2.7557314297e-7f))));
  const int q = k & 3;
  s = (q == 0) ? sp : (q == 1) ? cp : (q == 2) ? -sp : -cp;
  c = (q == 0) ? cp : (q == 1) ? -sp : (q == 2) ? -cp : sp;
}

__device__ __forceinline__ void transpose_item(const float* W, int K, int N, bf16_t* WT, int k0, int n0, int drow0, LAS float* scr, int lane) {
  float wv[32];
#pragma unroll
  for (int i = 0; i < 32; ++i) { const int kk = 2 * i + (lane >> 5); wv[i] = W[(size_t)(k0 + kk) * N + n0 + (lane & 31)]; }
#pragma unroll
  for (int i = 0; i < 32; ++i) { const int kk = 2 * i + (lane >> 5); scr[kk * 33 + (lane & 31)] = wv[i]; }
  asm volatile("s_waitcnt lgkmcnt(0)" ::: "memory");
  const int c = lane & 7;
#pragma unroll
  for (int j = 0; j < 4; ++j) { const int n = (lane >> 3) + 8 * j; const LAS float* s = scr + (8 * c) * 33 + n;
    u32x4 o; o.x = cvtpk(s[0 * 33], s[1 * 33]); o.y = cvtpk(s[2 * 33], s[3 * 33]); o.z = cvtpk(s[4 * 33], s[5 * 33]); o.w = cvtpk(s[6 * 33], s[7 * 33]);
    *(u32x4*)(WT + (size_t)(drow0 + n) * K + k0 + 8 * c) = o; }
  asm volatile("s_waitcnt lgkmcnt(0)" ::: "memory");
}

__device__ __forceinline__ void phase_setup(const Params& p, LAS unsigned char* lds) {
  const int tid = otid(), wid = tid >> 6, lane = tid & 63;
  unsigned char* ws = p.ws;
  {
    LAS float* sl = (LAS float*)lds; LAS float* red = sl + 4096;
    const float* cin = p.in[1]; const float* wada = p.in[2]; const float* bada = p.in[3]; float* mod = (float*)(ws + WS_MOD);
    for (int j = obid(); j < 256; j += gridDim.x) {
      for (int i = tid; i < 4096; i += NTHREADS) { const float v = cin[i]; sl[i] = v / (1.f + __expf(-v)); }
      __syncthreads();
      const int cq = tid % 18, ks = tid / 18;
      f32x4 a0 = {0.f, 0.f, 0.f, 0.f}, a1 = {0.f, 0.f, 0.f, 0.f};
      if (ks < 28) {
        const float* wp = wada + (size_t)j * 72 + 4 * cq;
#pragma unroll 16
        for (int k = ks; k < 2048; k += 28) { const f32x4 w = *(const f32x4*)(wp + (size_t)k * NMOD); const float s0 = sl[k], s1 = sl[2048 + k]; a0 += w * s0; a1 += w * s1; }
        LAS float* rp = red + (ks * 18 + cq) * 8;
        rp[0] = a0[0]; rp[1] = a0[1]; rp[2] = a0[2]; rp[3] = a0[3]; rp[4] = a1[0]; rp[5] = a1[1]; rp[6] = a1[2]; rp[7] = a1[3];
      }
      __syncthreads();
      if (tid < 144) { const int b = tid / 72, cc = tid % 72, q = cc >> 2, e = cc & 3; float s = 0.f;
        for (int k = 0; k < 28; ++k) s += red[(k * 18 + q) * 8 + b * 4 + e];
        mod[(size_t)b * NMOD + j * 72 + cc] = s + bada[j * 72 + cc]; }
      __syncthreads();
    }
  }
  {
    float* cs = (float*)(ws + WS_CS);
    for (int e = obid() * NTHREADS + tid; e < 4096; e += gridDim.x * NTHREADS) {
      const int pos = e >> 5, i = e & 31;
      const float f = __builtin_amdgcn_exp2f(-0.4152410118609203f * (float)i);
      const float ang = (float)pos * f; float c, s; sincos_f(ang, c, s);
      cs[2 * e] = c; cs[2 * e + 1] = s;
    }
  }
  {
    LAS float* scr = (LAS float*)lds + wid * (64 * 33);
    const int gw = obid() * 8 + wid, GW = gridDim.x * 8;
    for (int it = gw; it < 47616; it += GW) {
      int job, li;
      if (it < 5632) { job = 0; li = it; } else if (it < 11264) { job = 1; li = it - 5632; } else if (it < 16896) { job = 2; li = it - 11264; }
      else if (it < 27136) { job = 3; li = it - 16896; } else if (it < 27648) { job = 4; li = it - 27136; } else if (it < 28672) { job = 5; li = it - 27648; }
      else if (it < 30720) { job = 6; li = it - 28672; } else if (it < 36352) { job = 7; li = it - 30720; } else if (it < 41984) { job = 8; li = it - 36352; } else { job = 9; li = it - 41984; }
      const float* W; int K, N; size_t dst; int mode = 0;
      switch (job) {
        case 0: W = p.in[5];  K = DM;  N = DFF; dst = WS_W13_1; mode = 1; break;
        case 1: W = p.in[6];  K = DM;  N = DFF; dst = WS_W13_1; mode = 2; break;
        case 2: W = p.in[7];  K = DFF; N = DM;  dst = WS_W2_1; break;
        case 3: W = p.in[9];  K = DM;  N = DIN; dst = WS_WIN; break;
        case 4: W = p.in[14]; K = 512; N = DM;  dst = WS_WBA; break;
        case 5: W = p.in[15]; K = 1024; N = DM; dst = WS_WBB; break;
        case 6: W = p.in[16]; K = DM;  N = DM;  dst = WS_WOUT; break;
        case 7: W = p.in[18]; K = DM;  N = DFF; dst = WS_W13_2; mode = 1; break;
        case 8: W = p.in[19]; K = DM;  N = DFF; dst = WS_W13_2; mode = 2; break;
        default: W = p.in[20]; K = DFF; N = DM; dst = WS_W2_2; break;
      }
      const int nblk = N / 32, kb = li / nblk, nb = li % nblk, n0 = nb * 32;
      int drow0 = n0;
      if (mode) drow0 = (n0 >> 7) * 256 + (n0 & 127) + (mode == 2 ? 128 : 0);
      transpose_item(W, K, N, (bf16_t*)(ws + dst), kb * 64, n0, drow0, scr, lane);
    }
  }
}

template <bool ADD, bool SRC16>
__device__ __forceinline__ void phase_norm(const void* src, const bf16_t* D, unsigned short* hout, const float* gain, const float* shift, const float* scale, bf16_t* dst) {
  const int tid = otid(), wid = tid >> 6, lane = tid & 63;
  const int stride = gridDim.x * 8;
  int curb = -1; f32x4 av[8], sv[8];
  for (int row = obid() * 8 + wid; row < MTOK; row += 2 * stride) {
    const int row2 = row + stride; const bool two = (row2 < MTOK) && ((row2 >> 13) == (row >> 13));
    const int b = row >> 13;
    if (b != curb) { curb = b;
      const f32x4* gp = (const f32x4*)gain + lane; const f32x4* shp = (const f32x4*)(shift + (size_t)b * NMOD) + lane; const f32x4* scp = (const f32x4*)(scale + (size_t)b * NMOD) + lane;
#pragma unroll
      for (int j = 0; j < 8; ++j) { av[j] = gp[64 * j] * (scp[64 * j] + 1.f); sv[j] = shp[64 * j]; } }
    const int rb = two ? row2 : row;
    f32x4 v0[8], v1[8]; u32x2 d0[8], d1[8], g0[8], g1[8]; float s0 = 0.f, s1 = 0.f;
    if (SRC16) { const u32x2* x0 = (const u32x2*)((const unsigned short*)src + (size_t)row * DM) + lane; const u32x2* x1 = (const u32x2*)((const unsigned short*)src + (size_t)rb * DM) + lane;
#pragma unroll
      for (int j = 0; j < 8; ++j) { g0[j] = x0[64 * j]; g1[j] = x1[64 * j]; } }
    else { const f32x4* x0 = (const f32x4*)((const float*)src + (size_t)row * DM) + lane; const f32x4* x1 = (const f32x4*)((const float*)src + (size_t)rb * DM) + lane;
#pragma unroll
      for (int j = 0; j < 8; ++j) { v0[j] = x0[64 * j]; v1[j] = x1[64 * j]; } }
    if (ADD) {
      const u32x2* e0 = (const u32x2*)(D + (size_t)row * DM) + lane; const u32x2* e1 = (const u32x2*)(D + (size_t)rb * DM) + lane;
#pragma unroll
      for (int j = 0; j < 8; ++j) { d0[j] = e0[64 * j]; d1[j] = e1[64 * j]; }
    }
    asm volatile("" ::: "memory");
    if (SRC16) {
#pragma unroll
      for (int j = 0; j < 8; ++j) { v0[j] = unpk_h4(g0[j]); v1[j] = unpk_h4(g1[j]); } }
    if (ADD) {
#pragma unroll
      for (int j = 0; j < 8; ++j) { v0[j] += unpk_b4(d0[j]); v1[j] += unpk_b4(d1[j]); }
    }
#pragma unroll
    for (int j = 0; j < 8; ++j) { s0 += (v0[j][0] * v0[j][0] + v0[j][1] * v0[j][1]) + (v0[j][2] * v0[j][2] + v0[j][3] * v0[j][3]);
                                  s1 += (v1[j][0] * v1[j][0] + v1[j][1] * v1[j][1]) + (v1[j][2] * v1[j][2] + v1[j][3] * v1[j][3]); }
#pragma unroll
    for (int o = 1; o < 64; o <<= 1) { s0 += __shfl_xor(s0, o); s1 += __shfl_xor(s1, o); }
    const float r0 = 1.0f / sqrtf(s0 * (1.f / DM) + EPS), r1 = 1.0f / sqrtf(s1 * (1.f / DM) + EPS);
    u32x2* o0 = (u32x2*)(dst + (size_t)row * DM) + lane; u32x2* o1 = (u32x2*)(dst + (size_t)row2 * DM) + lane;
    if (ADD) { u32x2* h0 = (u32x2*)(hout + (size_t)row * DM) + lane;
#pragma unroll
      for (int j = 0; j < 8; ++j) { u32x2 w; w.x = pkh(v0[j][0], v0[j][1]); w.y = pkh(v0[j][2], v0[j][3]); h0[64 * j] = w; } }
#pragma unroll
    for (int j = 0; j < 8; ++j) { const f32x4 y = v0[j] * r0 * av[j] + sv[j]; u32x2 w; w.x = cvtpk(y[0], y[1]); w.y = cvtpk(y[2], y[3]); o0[64 * j] = w; }
    if (two) {
      if (ADD) { u32x2* h1 = (u32x2*)(hout + (size_t)row2 * DM) + lane;
#pragma unroll
        for (int j = 0; j < 8; ++j) { u32x2 w; w.x = pkh(v1[j][0], v1[j][1]); w.y = pkh(v1[j][2], v1[j][3]); h1[64 * j] = w; } }
#pragma unroll
      for (int j = 0; j < 8; ++j) { const f32x4 y = v1[j] * r1 * av[j] + sv[j]; u32x2 w; w.x = cvtpk(y[0], y[1]); w.y = cvtpk(y[2], y[3]); o1[64 * j] = w; }
    } else if (row2 < MTOK) {
      row -= stride;
    }
  }
}
__device__ __forceinline__ void phase_final(const unsigned short* h, const bf16_t* D, const float* gain, float* out) {
  const int tid = otid(), wid = tid >> 6, lane = tid & 63;
  const int stride = gridDim.x * 8;
  f32x4 gv[8];
  { const f32x4* gp = (const f32x4*)gain + lane;
#pragma unroll
    for (int j = 0; j < 8; ++j) gv[j] = gp[64 * j]; }
  for (int row = obid() * 8 + wid; row < MTOK; row += 2 * stride) {
    const int row2 = row + stride; const bool two = row2 < MTOK; const int rb = two ? row2 : row;
    const u32x2* x0 = (const u32x2*)(h + (size_t)row * DM) + lane; const u32x2* x1 = (const u32x2*)(h + (size_t)rb * DM) + lane;
    const u32x2* e0 = (const u32x2*)(D + (size_t)row * DM) + lane; const u32x2* e1 = (const u32x2*)(D + (size_t)rb * DM) + lane;
    f32x4 v0[8], v1[8]; u32x2 g0[8], g1[8], d0[8], d1[8]; float s0 = 0.f, s1 = 0.f;
#pragma unroll
    for (int j = 0; j < 8; ++j) { g0[j] = x0[64 * j]; g1[j] = x1[64 * j]; d0[j] = e0[64 * j]; d1[j] = e1[64 * j]; }
    asm volatile("" ::: "memory");
#pragma unroll
    for (int j = 0; j < 8; ++j) { v0[j] = unpk_h4(g0[j]) + unpk_b4(d0[j]); v1[j] = unpk_h4(g1[j]) + unpk_b4(d1[j]); }
#pragma unroll
    for (int j = 0; j < 8; ++j) { s0 += (v0[j][0] * v0[j][0] + v0[j][1] * v0[j][1]) + (v0[j][2] * v0[j][2] + v0[j][3] * v0[j][3]);
                                  s1 += (v1[j][0] * v1[j][0] + v1[j][1] * v1[j][1]) + (v1[j][2] * v1[j][2] + v1[j][3] * v1[j][3]); }
#pragma unroll
    for (int o = 1; o < 64; o <<= 1) { s0 += __shfl_xor(s0, o); s1 += __shfl_xor(s1, o); }
    const float r0 = 1.0f / sqrtf(s0 * (1.f / DM) + EPS), r1 = 1.0f / sqrtf(s1 * (1.f / DM) + EPS);
    f32x4* y0 = (f32x4*)(out + (size_t)row * DM) + lane; f32x4* y1 = (f32x4*)(out + (size_t)row2 * DM) + lane;
#pragma unroll
    for (int j = 0; j < 8; ++j) y0[64 * j] = v0[j] * r0 * gv[j];
    if (two) {
#pragma unroll
      for (int j = 0; j < 8; ++j) y1[64 * j] = v1[j] * r1 * gv[j];
    }
  }
}
struct PrepTok { u32x4 raw[9]; u32x4 vraw; f32x4 cs[4]; };
__device__ __forceinline__ void prep_load(PrepTok& d, const bf16_t* proj, const float* cs, int row, int lane, int hq, int e0) {
  const int t = row & (SEQ - 1);
  const bf16_t* pr = proj + (size_t)row * DIN;
#pragma unroll
  for (int i = 3; i < 9; ++i) { if (i == 6 || i == 7) continue; const int head = 4 * i + hq; const int off = head * 128 + (i >= 6 ? 1536 : 0) + e0;
    d.raw[i] = (i < 8 || hq < 2) ? *(const u32x4*)(pr + off) : (u32x4){0u, 0u, 0u, 0u}; }
  d.vraw = (u32x4){0u, 0u, 0u, 0u};
  if (lane < 32) d.vraw = *(const u32x4*)(pr + OFF_VB + lane * 8);
  const int ee = e0 & 63, pos = (ee < 32) ? (t >> 6) : (t & 63);
  const f32x4* csp = (const f32x4*)(cs + 2 * (pos * 32 + (ee & 31)));
  d.cs[0] = csp[0]; d.cs[1] = csp[1]; d.cs[2] = csp[2]; d.cs[3] = csp[3];
}
__device__ __forceinline__ void phase_prep(const Params& p) {
  const int tid = otid(), wid = tid >> 6, lane = tid & 63, j16 = lane & 15, hq = lane >> 4, e0 = j16 * 8;
  bf16_t* proj = (bf16_t*)(p.ws + WS_P); const float* cs = (const float*)(p.ws + WS_CS);
  bf16_t* kbc = (bf16_t*)(p.ws + WS_KBC); bf16_t* vbc = (bf16_t*)(p.ws + WS_VBC);
  float gq_a[8], gk_a[8], gq_b[8], gk_b[8];
#pragma unroll
  for (int e = 0; e < 8; ++e) { gq_a[e] = p.in[10][e0 + e]; gk_a[e] = p.in[11][e0 + e]; gq_b[e] = p.in[12][e0 + e]; gk_b[e] = p.in[13][e0 + e]; }
  const float ssign = (j16 < 8) ? -1.f : 1.f;
  const int stride = gridDim.x * 8;
  int row = obid() * 8 + wid;
  PrepTok cur, nxt;
  if (row < MTOK) prep_load(cur, proj, cs, row, lane, hq, e0);
  for (; row < MTOK; row += stride) {
    const int rown = row + stride;
    if (rown < MTOK) prep_load(nxt, proj, cs, rown, lane, hq, e0);
    asm volatile("" ::: "memory");
    const int t = row & (SEQ - 1), bb = row >> 13;
    bf16_t* pr = proj + (size_t)row * DIN;
    const float cv[8] = {cur.cs[0][0], cur.cs[0][2], cur.cs[1][0], cur.cs[1][2], cur.cs[2][0], cur.cs[2][2], cur.cs[3][0], cur.cs[3][2]};
    const float sv[8] = {cur.cs[0][1], cur.cs[0][3], cur.cs[1][1], cur.cs[1][3], cur.cs[2][1], cur.cs[2][3], cur.cs[3][1], cur.cs[3][3]};
#pragma unroll
    for (int i = 3; i < 9; ++i) {
      if (i == 6 || i == 7) continue;
      const u32x4 rw = cur.raw[i];
      float x[8] = {bflo(rw.x), bfhi(rw.x), bflo(rw.y), bfhi(rw.y), bflo(rw.z), bfhi(rw.z), bflo(rw.w), bfhi(rw.w)};
      float ss = 0.f;
#pragma unroll
      for (int e = 0; e < 8; ++e) ss += x[e] * x[e];
      ss += __shfl_xor(ss, 1); ss += __shfl_xor(ss, 2); ss += __shfl_xor(ss, 4); ss += __shfl_xor(ss, 8);
      const float rs = 1.0f / sqrtf(ss * (1.f / 128.f) + EPS);
      float y[8];
#pragma unroll
      for (int e = 0; e < 8; ++e) y[e] = x[e] * rs * ((i < 3) ? gq_a[e] : (i < 6) ? gk_a[e] : (i < 8) ? gq_b[e] : gk_b[e]);
      if (i >= 6) {
#pragma unroll
        for (int e = 0; e < 8; ++e) { const float yp = __shfl_xor(y[e], 8); y[e] = y[e] * cv[e] + ssign * yp * sv[e]; }
      }
      u32x4 w; w.x = cvtpk(y[0], y[1]); w.y = cvtpk(y[2], y[3]); w.z = cvtpk(y[4], y[5]); w.w = cvtpk(y[6], y[7]);
      const int head = 4 * i + hq;
      if (i < 8) *(u32x4*)(pr + head * 128 + (i >= 6 ? 1536 : 0) + e0) = w;
      else if (hq < 2) *(u32x4*)(kbc + ((size_t)(bb * 2 + hq) * SEQ + t) * 128 + e0) = w;
    }
    if (lane < 32) *(u32x4*)(vbc + ((size_t)(bb * 2 + (lane >> 4)) * SEQ + t) * 128 + e0) = cur.vraw;
    asm volatile("" ::: "memory");
    cur = nxt;
  }
}
__device__ __forceinline__ void phase_attn_dense(const Params& p, unsigned char* shm, int vcu) {
  const bf16_t* proj = (const bf16_t*)(p.ws + WS_P);
  bf16_t* outb = (bf16_t*)(p.ws + WS_OUTB);
  const bf16_t* kbc = (const bf16_t*)(p.ws + WS_KBC); const bf16_t* vbc = (const bf16_t*)(p.ws + WS_VBC);
  for (int u = vcu; u < 512; u += gridDim.x) {
    const int x8 = u & 7, j32 = (u >> 3) & 31, b = u >> 8, kvh = x8 & 1, idx = (x8 >> 1) * 32 + j32, h = kvh * 4 + (idx & 3), qb = idx >> 2;
    const size_t r0 = (size_t)b * SEQ;
    attn_dense_body(proj + (r0 + qb * 256) * DIN + OFF_QB + h * 128, kbc + (size_t)(b * 2 + kvh) * SEQ * 128, vbc + (size_t)(b * 2 + kvh) * SEQ * 128,
                    outb + (r0 + qb * 256) * 1024 + h * 128, SEQ, (char*)shm, p.in[12], (const float*)(p.ws + WS_CS), qb * 256);
  }
}
__device__ __forceinline__ void phase_attn_dil(const Params& p, unsigned char* shm) {
  const int tid = otid(), wid = tid >> 6, lane = tid & 63;
  const bf16_t* proj = (const bf16_t*)(p.ws + WS_P);
  LAS char* wl = (LAS char*)shm + wid * (16384 + 256);
  bf16_t* PA = (bf16_t*)(p.ws + WS_U); float* LSE = (float*)(p.ws + WS_LSE);
  for (int it = obid() * 8 + wid; it < 6144; it += gridDim.x * 8) mixa_item(proj, PA, LSE, it, wl, lane, p.in[10]);
}
struct CombIn { float l0, l1, l2; u32x4 a, b, c; };
__device__ __forceinline__ void comb_load(CombIn& d, const bf16_t* PA, const float* LSE, int i) {
  const int row = i >> 6, c8 = (i & 63) * 8, h = c8 >> 7;
  d.l0 = LSE[((size_t)0 * MTOK + row) * 4 + h]; d.l1 = LSE[((size_t)1 * MTOK + row) * 4 + h]; d.l2 = LSE[((size_t)2 * MTOK + row) * 4 + h];
  d.a = *(const u32x4*)(PA + ((size_t)0 * MTOK + row) * 512 + c8); d.b = *(const u32x4*)(PA + ((size_t)1 * MTOK + row) * 512 + c8); d.c = *(const u32x4*)(PA + ((size_t)2 * MTOK + row) * 512 + c8);
}
__device__ __forceinline__ void comb_store(const CombIn& d, bf16_t* outa, int i) {
  const int row = i >> 6, c8 = (i & 63) * 8;
  const float mx = fmaxf(d.l0, fmaxf(d.l1, d.l2));
  float w0 = __builtin_amdgcn_exp2f(d.l0 - mx), w1 = __builtin_amdgcn_exp2f(d.l1 - mx), w2 = __builtin_amdgcn_exp2f(d.l2 - mx);
  const float inv = 1.f / (w0 + w1 + w2); w0 *= inv; w1 *= inv; w2 *= inv;
  const u32x4 a = d.a, b = d.b, c = d.c;
  u32x4 o;
  o.x = cvtpk(w0 * bflo(a.x) + w1 * bflo(b.x) + w2 * bflo(c.x), w0 * bfhi(a.x) + w1 * bfhi(b.x) + w2 * bfhi(c.x));
  o.y = cvtpk(w0 * bflo(a.y) + w1 * bflo(b.y) + w2 * bflo(c.y), w0 * bfhi(a.y) + w1 * bfhi(b.y) + w2 * bfhi(c.y));
  o.z = cvtpk(w0 * bflo(a.z) + w1 * bflo(b.z) + w2 * bflo(c.z), w0 * bfhi(a.z) + w1 * bfhi(b.z) + w2 * bfhi(c.z));
  o.w = cvtpk(w0 * bflo(a.w) + w1 * bflo(b.w) + w2 * bflo(c.w), w0 * bfhi(a.w) + w1 * bfhi(b.w) + w2 * bfhi(c.w));
  *(u32x4*)(outa + (size_t)row * 512 + c8) = o;
}
__device__ __forceinline__ void phase_combine(const Params& p) {
  const bf16_t* PA = (const bf16_t*)(p.ws + WS_U); const float* LSE = (const float*)(p.ws + WS_LSE); bf16_t* outa = (bf16_t*)(p.ws + WS_OUTA);
  const int stride = gridDim.x * NTHREADS;
  for (int i = obid() * NTHREADS + otid(); i < MTOK * 64; i += 2 * stride) {
    const int i2 = i + stride; const bool two = i2 < MTOK * 64;
    CombIn d0, d1;
    comb_load(d0, PA, LSE, i); comb_load(d1, PA, LSE, two ? i2 : i);
    asm volatile("" ::: "memory");
    comb_store(d0, outa, i); if (two) comb_store(d1, outa, i2);
  }
}

#define XB_TMO      128
#define XB_XCNT(j)  (256  + 64 * (j))
#define XB_XSUB(j)  (1280 + 64 * (j))
#define XB_XGEN(j)  (2304 + 64 * (j))
#define XB_TOP      3328
#define XB_TOPGEN   3392
#define XCD_BAR_WORDS 3456
#define XB_SPIN_CAP (1u << 22)

__device__ __forceinline__ unsigned xb_ld(unsigned* p)              { return __hip_atomic_load(p, __ATOMIC_RELAXED, __HIP_MEMORY_SCOPE_AGENT); }
__device__ __forceinline__ unsigned xb_add(unsigned* p, unsigned v) { return __hip_atomic_fetch_add(p, v, __ATOMIC_RELAXED, __HIP_MEMORY_SCOPE_AGENT); }
__device__ __forceinline__ unsigned xb_xcc_id() { return (unsigned)__builtin_amdgcn_s_getreg((3 << 11) | 20) & 0xFu; }
#define XB_SPIN(cond, bar) do { unsigned _sp = 0; while (cond) { __builtin_amdgcn_s_sleep(1); \
    if ((++_sp & 255u) == 0u) { if (xb_ld(&(bar)[XB_TMO])) break; if (_sp > XB_SPIN_CAP) { atomicAdd(&(bar)[XB_TMO], 1u); break; } } } } while (0)

struct XcdBarrier {
    unsigned* bar; unsigned x;
    volatile LAS unsigned* st;
};

__device__ __forceinline__ XcdBarrier xcd_barrier_post(unsigned* bar, volatile LAS unsigned* st) {
    XcdBarrier b; b.bar = bar; b.x = xb_xcc_id(); b.st = st;
    if (threadIdx.x == 0) st[3] = xb_add(&bar[XB_XCNT(b.x)], 1u);
    return b;
}
__device__ __forceinline__ void xcd_barrier_complete(unsigned* bar, unsigned x, unsigned& nloc, unsigned& nx, unsigned& uniform) {
    const unsigned G = gridDim.x * gridDim.y * gridDim.z;
    unsigned sum, cnt, mine, okc, sp = 0u;
    for (;;) {
        sum = 0u; cnt = 0u; mine = 0u; okc = 0u;
#pragma unroll
        for (unsigned j = 0; j < 16; ++j) { const unsigned c = xb_ld(&bar[XB_XCNT(j)]); sum += c; cnt += (c > 0u) ? 1u : 0u; mine = (j == x) ? c : mine; okc += (c == ((j < 8u) ? (G >> 3) : 0u)) ? 1u : 0u; }
        if (sum == G) break;
        __builtin_amdgcn_s_sleep(1);
        if ((++sp & 255u) == 0u) { if (xb_ld(&bar[XB_TMO])) break; if (sp > XB_SPIN_CAP) { atomicAdd(&bar[XB_TMO], 1u); break; } }
    }
    nloc = mine > 0u ? mine : 1u; nx = cnt > 0u ? cnt : 1u; uniform = (sum == G && (G & 7u) == 0u && okc == 16u) ? 1u : 0u;
}

__device__ __forceinline__ void xcd_barrier(const XcdBarrier& b) {
    asm volatile("s_waitcnt vmcnt(0)" ::: "memory");
    __syncthreads();
    if (threadIdx.x == 0) {
        unsigned* bar = b.bar;
        __builtin_amdgcn_s_waitcnt(0);
        unsigned nloc = b.st[0], nx = b.st[1];
        if (nloc == 0u) { unsigned uni; xcd_barrier_complete(bar, b.x, nloc, nx, uni); b.st[0] = nloc; b.st[1] = nx; b.st[2] = uni; }
        const unsigned old = xb_add(&bar[XB_XSUB(b.x)], 1u);
        const unsigned gen = old / nloc;
        if (old + 1u == (gen + 1u) * nloc) {
            __builtin_amdgcn_fence(__ATOMIC_RELEASE, "agent");
            asm volatile("s_waitcnt vmcnt(0)" ::: "memory");
            const unsigned og = xb_add(&bar[XB_TOP], 1u);
            const unsigned tg = og / nx;
            if (og + 1u == (tg + 1u) * nx) xb_add(&bar[XB_TOPGEN], 1u);
            else XB_SPIN(xb_ld(&bar[XB_TOPGEN]) == tg, bar);
            __builtin_amdgcn_fence(__ATOMIC_ACQUIRE, "agent");
            asm volatile("s_waitcnt vmcnt(0)" ::: "memory");
        } else {
            XB_SPIN(xb_ld(&bar[XB_TOPGEN]) == gen, bar);
            __builtin_amdgcn_fence(__ATOMIC_ACQUIRE, "agent");
            asm volatile("s_waitcnt vmcnt(0)" ::: "memory");
        }
    }
    __syncthreads();
}


constexpr int NPH = 17;
__global__ void __launch_bounds__(NTHREADS) mega(Params p) {
  extern __shared__ __attribute__((aligned(16))) unsigned char shm[];
  LAS unsigned char* lds = (LAS unsigned char*)shm;
  cg::grid_group grid = cg::this_grid();
  unsigned char* ws = p.ws;
  float* mod = (float*)(ws + WS_MOD);
  bf16_t* U = (bf16_t*)(ws + WS_U); bf16_t* P = (bf16_t*)(ws + WS_P);
  volatile LAS unsigned* xst = (volatile LAS unsigned*)(lds + LDS_BYTES - 16);
  if (threadIdx.x == 0) { xst[0] = 0u; xst[1] = 0u; xst[2] = 0u; xst[3] = 0u; }
  __syncthreads();
  const XcdBarrier xb = xcd_barrier_post((unsigned*)(ws + WS_BAR), xst);
  for (int ph = p.ph_lo; ph < p.ph_hi; ++ph) {
    if (ph == 11) { asm volatile("s_waitcnt vmcnt(0)" ::: "memory"); __syncthreads(); }
    if (ph > p.ph_lo && ph != 8 && ph != 11) { if (p.ph_hi < 0) grid.sync(); else xcd_barrier(xb); }
    int vcu = blockIdx.x;
    if (ph >= 1 && xst[2] != 0u) vcu = (int)(xb.x + 8u * xst[3]);
    vcu = __builtin_amdgcn_readfirstlane(vcu); asm volatile("" : "+s"(vcu));
    switch (ph) {
      case 0: phase_setup(p, lds); break;
      case 1: phase_norm<false, false>(p.in[0], nullptr, nullptr, p.in[4], mod, mod + DM, U); break;
      case 4: phase_norm<true, false>(p.in[0], U, (unsigned short*)(ws + WS_H16), p.in[8], mod + 3 * DM, mod + 4 * DM, U); break;
      case 13: phase_norm<true, true>(ws + WS_H16, (const bf16_t*)(ws + WS_D2), (unsigned short*)(ws + WS_H16), p.in[17], mod + 6 * DM, mod + 7 * DM, U); break;
      case 2: case 14: {
        pg8::Gemm g; g.A = U; g.Bt = (const bf16_t*)(ws + (ph == 2 ? WS_W13_1 : WS_W13_2)); g.M = MTOK; g.N = 2 * DFF; g.K = DM;
        pg8::StaticOrder S; S.init(g.M, g.N, gridDim.x, vcu);
        pg8::EpiSwiGLU E; E.O = P; E.ldc = DFF;
        pg8::gemm_phase<pg8::EpiSwiGLU, pg8::StaticOrder, true, true>(lds, g, S, E);
      } break;
      case 3: case 12: case 15: {
        pg8::Gemm g; g.M = MTOK; g.N = DM;
        pg8::EpiDelta E;
        if (ph == 3) { g.A = P; g.Bt = (const bf16_t*)(ws + WS_W2_1); g.K = DFF; E.D = U; E.gate = mod + 2 * DM; E.coef = 0.5f; }
        else if (ph == 12) { g.A = U; g.Bt = (const bf16_t*)(ws + WS_WOUT); g.K = DM; E.D = (bf16_t*)(ws + WS_D2); E.gate = mod + 5 * DM; E.coef = 1.0f; }
        else { g.A = P; g.Bt = (const bf16_t*)(ws + WS_W2_2); g.K = DFF; E.D = U; E.gate = mod + 8 * DM; E.coef = 0.5f; }
        pg8::StaticOrder S; S.init(g.M, g.N, gridDim.x, vcu);
        pg8::gemm_phase<pg8::EpiDelta, pg8::StaticOrder, true, true>(lds, g, S, E);
      } break;
      case 5: {
        pg8::Gemm g; g.A = U; g.Bt = (const bf16_t*)(ws + WS_WIN); g.M = MTOK; g.N = DIN; g.K = DM;
        pg8::StaticOrder S; S.init(g.M, g.N, gridDim.x, vcu);
        pg8::EpiProj E; E.O = P; E.ldc = DIN;
        pg8::gemm_phase<pg8::EpiProj, pg8::StaticOrder, true, true>(lds, g, S, E);
      } break;
      case 6: phase_prep(p); break;
      case 7: phase_attn_dense(p, shm, vcu); break;
      case 8: __syncthreads(); phase_attn_dil(p, shm); break;
      case 9: phase_combine(p); break;
      case 10: {
        pg8::Gemm g; g.A = (const bf16_t*)(ws + WS_OUTA); g.Bt = (const bf16_t*)(ws + WS_WBA); g.M = MTOK; g.N = DM; g.K = 512;
        pg8::StaticOrder S; S.init(g.M, g.N, gridDim.x, vcu);
        pg8::EpiGate<false> E; E.T = U; E.G = P + OFF_GA; E.ldg = DIN;
        pg8::gemm_phase<pg8::EpiGate<false>, pg8::StaticOrder, true, true>(lds, g, S, E);
      } break;
      case 11: {
        pg8::Gemm g; g.A = (const bf16_t*)(ws + WS_OUTB); g.Bt = (const bf16_t*)(ws + WS_WBB); g.M = MTOK; g.N = DM; g.K = 1024;
        pg8::StaticOrder S; S.init(g.M, g.N, gridDim.x, vcu);
        pg8::EpiGate<true> E; E.T = U; E.G = P + OFF_GB; E.ldg = DIN;
        pg8::gemm_phase<pg8::EpiGate<true>, pg8::StaticOrder, true, true>(lds, g, S, E);
      } break;
      default: phase_final((const unsigned short*)(ws + WS_H16), U, p.in[21], p.out); break;
    }
  }
}

extern "C" void kernel_launch(void* const* d_in, const int* in_sizes, int n_in, void* d_out, int out_size, void* d_ws, size_t ws_size, hipStream_t stream) {
  static int grid = 0;
  if (grid == 0) {
    if (n_in != 22 || in_sizes[0] != MTOK * DM || out_size != MTOK * DM || ws_size < WS_END) {
      fprintf(stderr, "kernel_launch: shape/workspace mismatch: n_in %d in0 %d out %d ws %zu (need %zu)\n", n_in, n_in > 0 ? in_sizes[0] : -1, out_size, ws_size, (size_t)WS_END); grid = -1; return; }
    int dev = 0, cus = 0, per_cu = 0;
    if (hipGetDevice(&dev) != hipSuccess || hipDeviceGetAttribute(&cus, hipDeviceAttributeMultiprocessorCount, dev) != hipSuccess) { fprintf(stderr, "kernel_launch: device query failed\n"); grid = -1; return; }
    if (hipFuncSetAttribute((const void*)mega, hipFuncAttributeMaxDynamicSharedMemorySize, LDS_BYTES) != hipSuccess) { fprintf(stderr, "kernel_launch: hipFuncSetAttribute failed\n"); grid = -1; return; }
    if (hipOccupancyMaxActiveBlocksPerMultiprocessor(&per_cu, (const void*)mega, NTHREADS, LDS_BYTES) != hipSuccess || per_cu < 1) { fprintf(stderr, "kernel_launch: occupancy query gives %d\n", per_cu); per_cu = 1; (void)hipGetLastError(); }
    grid = cus * per_cu;
  }
  if (grid < 0) return;
  Params p{};
  for (int i = 0; i < 22; ++i) p.in[i] = (const float*)d_in[i];
  p.out = (float*)d_out; p.ws = (unsigned char*)d_ws;
  if (hipMemsetAsync((char*)d_ws + WS_BAR, 0, 16384, stream) != hipSuccess) { fprintf(stderr, "kernel_launch: memset failed\n"); return; }
#ifdef MK_MULTI
  for (int ph = 0; ph < NPH; ++ph) { p.ph_lo = ph; p.ph_hi = ph + 1; hipLaunchKernelGGL(mega, dim3(grid), dim3(NTHREADS), LDS_BYTES, stream, p); }
#else
  p.ph_lo = 0; p.ph_hi = NPH;
  void* args[] = {&p};
  const hipError_t e = hipLaunchCooperativeKernel((const void*)mega, dim3(grid), dim3(NTHREADS), args, LDS_BYTES, stream);
  if (e != hipSuccess) fprintf(stderr, "kernel_launch: cooperative launch failed: %s (grid %d)\n", hipGetErrorString(e), grid);
#endif
}
```
